# Optimizing an MI355X kernel written in HIP

```python
import jax, jax.numpy as jnp
from jax import lax
import numpy as np

D_MODEL = 1024
BATCH = 32
SEQ = 2048
DEPTH = 2

CHUNK = 64
CONV_CH = 512
CONV_K = 31
RET_HEADS = 4
RET_DK = 64
RET_DV = 128
RET_THETA = 10000.0
FOX_HEADS = 8
FOX_DH = 64
FOX_QBLOCK = 128
A_VAL = 0
A_GATE = A_VAL + CONV_CH
R_Q = A_GATE + CONV_CH
R_K = R_Q + RET_HEADS * RET_DK
R_V = R_K + RET_HEADS * RET_DK
R_G = R_V + RET_HEADS * RET_DV
F_Q = R_G + RET_HEADS * RET_DV
F_K = F_Q + FOX_HEADS * FOX_DH
F_V = F_K + FOX_HEADS * FOX_DH
F_F = F_V + FOX_HEADS * FOX_DH
IN_COLS = F_F + FOX_HEADS
N_BRANCH = 3
N_EXPERTS = 16
N_GROUPS = 4
EXPERTS_PER_GROUP = N_EXPERTS // N_GROUPS
TOP_K = 2
D_FF = 2048
MOE_BLOCK = 128
DN_ALPHA = (2 * DEPTH) ** 0.25
DN_BETA = (8 * DEPTH) ** -0.25
LN_EPS = 1e-5

kernel_name = "chunk_causal_hybrid_conv_retention_fox_grouped_moe"


def layer_norm(x, g=None, b=None):
    xf = x.astype(jnp.float32)
    mu = jnp.mean(xf, axis=-1, keepdims=True)
    var = jnp.mean(jnp.square(xf - mu), axis=-1, keepdims=True)
    y = (xf - mu) * lax.rsqrt(var + LN_EPS)
    if g is not None:
        y = y * g.astype(jnp.float32) + b.astype(jnp.float32)
    return y.astype(x.dtype)


def rotary(x):
    S, d = x.shape[1], x.shape[-1]
    half = d // 2
    inv = RET_THETA ** (-jnp.arange(half, dtype=jnp.float32) / half)
    ang = jnp.arange(S, dtype=jnp.float32)[:, None] * inv[None, :]
    cos = jnp.cos(ang)[None, :, None, :]
    sin = jnp.sin(ang)[None, :, None, :]
    x1, x2 = x[..., :half], x[..., half:]
    return jnp.concatenate([x1 * cos - x2 * sin, x1 * sin + x2 * cos], axis=-1)


def conv_module(a_val, a_gate, conv_w, conv_b, ln_g, ln_b):
    h = a_val * jax.nn.sigmoid(a_gate)
    h = lax.conv_general_dilated(
        h, conv_w[:, None, :].astype(h.dtype), window_strides=(1,),
        padding=[(CONV_K - 1, 0)], dimension_numbers=('NWC', 'WIO', 'NWC'),
        feature_group_count=CONV_CH) + conv_b.astype(h.dtype)
    return jax.nn.silu(layer_norm(h, ln_g, ln_b))


def retention(q, k, v):
    B, S, H, dk = q.shape
    dv = v.shape[-1]
    nc = S // CHUNK
    log_gamma = jnp.log1p(-jnp.exp2(-5.0 - jnp.arange(H, dtype=jnp.float32)))
    j = jnp.arange(CHUNK, dtype=jnp.float32)
    intra_decay = jnp.exp(log_gamma[:, None, None] * jnp.abs(j[:, None] - j[None, :]))
    q_decay = jnp.exp(log_gamma[None, :] * (j[:, None] + 1.0))[None, :, :, None]
    k_decay = jnp.exp(log_gamma[None, :] * (CHUNK - 1.0 - j[:, None]))[None, :, :, None]
    chunk_decay = jnp.exp(log_gamma * CHUNK)[None, :, None, None]
    qc = q.reshape(B, nc, CHUNK, H, dk)
    kc = k.reshape(B, nc, CHUNK, H, dk)
    vc = v.reshape(B, nc, CHUNK, H, dv)
    scores = jnp.einsum('bnjhd,bnlhd->bnhjl', qc, kc) * intra_decay
    intra = jnp.einsum('bnhjl,bnlhe->bnjhe', scores, vc)

    def step(state, inp):
        qn, kn, vn = inp
        cross = jnp.einsum('bjhd,bhde->bjhe', qn, state) * q_decay
        state = state * chunk_decay + jnp.einsum('bjhd,bjhe->bhde', kn * k_decay, vn)
        return state, cross

    state0 = jnp.zeros((B, H, dk, dv), q.dtype)
    _, cross = lax.scan(step, state0, (qc.transpose(1, 0, 2, 3, 4), kc.transpose(1, 0, 2, 3, 4),
                                        vc.transpose(1, 0, 2, 3, 4)))
    cross = cross.transpose(1, 0, 2, 3, 4)
    return (intra + cross).reshape(B, S, H, dv)


def forgetting_attention(q, k, v, f_logit):
    B, S, H, dh = q.shape
    log_f = jax.nn.log_sigmoid(f_logit.astype(jnp.float32))
    cum = jnp.cumsum(log_f, axis=1).transpose(0, 2, 1)
    scale = dh ** -0.5
    pos = jnp.arange(S)
    outs = []
    for i in range(S // FOX_QBLOCK):
        q0, q1 = i * FOX_QBLOCK, (i + 1) * FOX_QBLOCK
        logits = jnp.einsum('bqhd,bkhd->bhqk', q[:, q0:q1], k[:, :q1]).astype(jnp.float32) * scale
        logits = logits + cum[:, :, q0:q1, None] - cum[:, :, None, :q1]
        mask = pos[q0:q1, None] >= pos[None, :q1]
        logits = jnp.where(mask, logits, -jnp.inf)
        p = jax.nn.softmax(logits, axis=-1).astype(v.dtype)
        outs.append(jnp.einsum('bhqk,bkhd->bqhd', p, v[:, :q1]))
    return jnp.concatenate(outs, axis=1)


def route(xt, w_router, b_router):
    T = xt.shape[0]
    s = jax.nn.sigmoid(xt.astype(jnp.float32) @ w_router.astype(jnp.float32))
    sel = (s + b_router.astype(jnp.float32)).reshape(T, N_GROUPS, EXPERTS_PER_GROUP)
    group_score = jnp.sum(lax.top_k(sel, TOP_K)[0], axis=-1)
    g = jnp.argmax(group_score, axis=-1)
    sel_g = jnp.take_along_axis(sel, g[:, None, None], axis=1)[:, 0]
    _, local = lax.top_k(sel_g, TOP_K)
    idx = g[:, None] * EXPERTS_PER_GROUP + local
    w = jnp.take_along_axis(s, idx, axis=1)
    return idx, w / jnp.sum(w, axis=-1, keepdims=True)


def moe_ffn(u, w_router, b_router, w1, w3, w2):
    B, S, D = u.shape
    T = B * S
    xt = u.reshape(T, D)
    idx, wts = route(xt, w_router, b_router)
    A = T * TOP_K
    flat_e = idx.reshape(A)
    flat_w = wts.reshape(A)
    flat_tok = jnp.repeat(jnp.arange(T, dtype=jnp.int32), TOP_K)
    order = jnp.argsort(flat_e)
    se = flat_e[order]
    counts = jnp.bincount(flat_e, length=N_EXPERTS)
    start = jnp.cumsum(counts) - counts
    padded = (counts + MOE_BLOCK - 1) // MOE_BLOCK * MOE_BLOCK
    pend = jnp.cumsum(padded)
    pstart = pend - padded
    dest = pstart[se] + jnp.arange(A) - start[se]
    P = A + N_EXPERTS * MOE_BLOCK
    NB = P // MOE_BLOCK
    buf_tok = jnp.full((P,), T, jnp.int32).at[dest].set(flat_tok[order])
    buf_w = jnp.zeros((P,), jnp.float32).at[dest].set(flat_w[order])
    block_e = jnp.minimum(jnp.searchsorted(pend, jnp.arange(NB) * MOE_BLOCK, side='right'), N_EXPERTS - 1)
    x_pad = jnp.concatenate([xt, jnp.zeros((1, D), xt.dtype)], axis=0)
    xb = x_pad[buf_tok].reshape(NB, MOE_BLOCK, D)

    def expert_block(args):
        xblk, e = args
        h = jax.nn.silu(xblk @ w1[e]) * (xblk @ w3[e])
        return h @ w2[e]

    yb = lax.map(expert_block, (xb, block_e)).reshape(P, D)
    out = jnp.zeros((T + 1, D), yb.dtype).at[buf_tok].add(yb * buf_w[:, None].astype(yb.dtype))
    return out[:T].reshape(B, S, D)


def setup_inputs(seed: int = 0) -> dict:
    key = jax.random.key(seed)
    ks = jax.random.split(key, 32)
    f32 = jnp.float32
    L, D = DEPTH, D_MODEL

    def nrm(k, shape, fan_in, gain=1.0):
        return jax.random.normal(k, shape, f32) * (gain * fan_in ** -0.5)

    def small(k, shape, s=0.02):
        return jax.random.normal(k, shape, f32) * s

    return {
        "x": jax.random.normal(ks[0], (BATCH, SEQ, D), f32),
        "c": jax.random.normal(ks[1], (BATCH, D), f32),
        "w_ada": nrm(ks[2], (L, D, 6 * D), D, 0.5),
        "b_ada": small(ks[3], (L, 6 * D)),
        "w_in": nrm(ks[4], (L, D, IN_COLS), D),
        "conv_w": nrm(ks[5], (L, CONV_K, CONV_CH), CONV_K),
        "conv_b": small(ks[6], (L, CONV_CH)),
        "conv_ln_g": 1.0 + small(ks[7], (L, CONV_CH)),
        "conv_ln_b": small(ks[8], (L, CONV_CH)),
        "b_forget": jax.random.uniform(ks[9], (L, FOX_HEADS), f32, 1.0, 5.0),
        "w_conv_out": nrm(ks[10], (L, CONV_CH, D), CONV_CH),
        "w_ret_out": nrm(ks[11], (L, RET_HEADS * RET_DV, D), RET_HEADS * RET_DV),
        "w_fox_out": nrm(ks[12], (L, FOX_HEADS * FOX_DH, D), FOX_HEADS * FOX_DH),
        "w_gate": nrm(ks[13], (L, D, N_BRANCH * D), D),
        "b_gate": small(ks[14], (L, N_BRANCH * D)),
        "w_out": nrm(ks[15], (L, D, D), D, DN_BETA),
        "ln1_g": 1.0 + small(ks[16], (L, D)),
        "ln1_b": small(ks[17], (L, D)),
        "w_router": nrm(ks[18], (D, N_EXPERTS), D),
        "b_router": small(ks[19], (N_EXPERTS,), 0.01),
        "w1": nrm(ks[20], (L, N_EXPERTS, D, D_FF), D),
        "w3": nrm(ks[21], (L, N_EXPERTS, D, D_FF), D),
        "w2": nrm(ks[22], (L, N_EXPERTS, D_FF, D), D_FF, DN_BETA),
        "ln2_g": 1.0 + small(ks[23], (L, D)),
        "ln2_b": small(ks[24], (L, D)),
    }


def reference(x, c, w_ada, b_ada, w_in, conv_w, conv_b, conv_ln_g, conv_ln_b, b_forget,
              w_conv_out, w_ret_out, w_fox_out, w_gate, b_gate, w_out, ln1_g, ln1_b,
              w_router, b_router, w1, w3, w2, ln2_g, ln2_b):
    B, S, D = x.shape
    for l in range(DEPTH):
        ada = jax.nn.silu(c) @ w_ada[l] + b_ada[l]
        sh1, sc1, g1, sh2, sc2, g2 = jnp.split(ada[:, None, :], 6, axis=-1)

        u = layer_norm(x) * (1.0 + sc1) + sh1
        z = u @ w_in[l]

        y_a = conv_module(z[..., A_VAL:A_GATE], z[..., A_GATE:R_Q], conv_w[l], conv_b[l],
                          conv_ln_g[l], conv_ln_b[l]) @ w_conv_out[l]

        rq = rotary(z[..., R_Q:R_K].reshape(B, S, RET_HEADS, RET_DK).astype(jnp.float32))
        rk = rotary(z[..., R_K:R_V].reshape(B, S, RET_HEADS, RET_DK).astype(jnp.float32)) * (RET_DK ** -0.5)
        rv = z[..., R_V:R_G].reshape(B, S, RET_HEADS, RET_DV).astype(jnp.float32)
        ry = layer_norm(retention(rq, rk, rv)).reshape(B, S, RET_HEADS * RET_DV).astype(z.dtype)
        y_b = (jax.nn.silu(z[..., R_G:F_Q]) * ry) @ w_ret_out[l]

        fq = z[..., F_Q:F_K].reshape(B, S, FOX_HEADS, FOX_DH)
        fk = z[..., F_K:F_V].reshape(B, S, FOX_HEADS, FOX_DH)
        fv = z[..., F_V:F_F].reshape(B, S, FOX_HEADS, FOX_DH)
        f_logit = z[..., F_F:IN_COLS] + b_forget[l]
        y_c = forgetting_attention(fq, fk, fv, f_logit).reshape(B, S, FOX_HEADS * FOX_DH) @ w_fox_out[l]

        ga, gb, gc = jnp.split(jax.nn.sigmoid(u @ w_gate[l] + b_gate[l]), N_BRANCH, axis=-1)
        h = (ga * y_a + gb * y_b + gc * y_c) @ w_out[l]
        x = layer_norm(DN_ALPHA * x + g1 * h, ln1_g[l], ln1_b[l])

        u2 = layer_norm(x) * (1.0 + sc2) + sh2
        h2 = moe_ffn(u2, w_router, b_router, w1[l], w3[l], w2[l])
        x = layer_norm(DN_ALPHA * x + g2 * h2, ln2_g[l], ln2_b[l])
    return x
```

```cpp
#include <hip/hip_runtime.h>
#include <cstdio>
#include <cstdint>
#include <cmath>
#include <hip/hip_bf16.h>

#ifndef MK_ONE_LAUNCH
#define MK_ONE_LAUNCH 1
#endif

#define LAS __attribute__((address_space(3)))
#define GAS __attribute__((address_space(1)))
typedef unsigned short bf16_t;
typedef short bf16x8 __attribute__((ext_vector_type(8)));
typedef float f32x4 __attribute__((ext_vector_type(4)));
typedef float f32x2 __attribute__((ext_vector_type(2)));
typedef unsigned u32x4 __attribute__((ext_vector_type(4)));
typedef unsigned u32x2 __attribute__((ext_vector_type(2)));
typedef GAS unsigned gu32;

constexpr int D = 1024, BATCH = 32, SEQ = 2048, T = BATCH * SEQ, DEPTH = 2;
constexpr int NHALF = 2, BH = BATCH / NHALF, TH = BH * SEQ;
constexpr int ZC = 4096, ZP = 4160  , GC = 3072, GP = 3200  , N1 = ZC + GC, INC = 4104;
constexpr int ACTC = 1536;
constexpr int NE = 16, FF = 2048, NPMAX = 528, PMAX = NPMAX * 256;
constexpr int C_AVAL = 0, C_AGATE = 512, C_RQ = 1024, C_RK = 1280, C_RV = 1536, C_RG = 2048, C_FQ = 2560, C_FK = 3072, C_FV = 3584;
constexpr float LN_EPS = 1e-5f;
constexpr float DN_ALPHA = 1.41421356237309515f;
constexpr int NSEG = 512, SEGROWS = 128;

constexpr size_t MiB = 1u << 20;
constexpr size_t WS_CTL = 0, CTL_ZERO_BYTES = 1 * MiB;
constexpr size_t WS_ADA = 1 * MiB;
constexpr size_t WS_ROT = 3 * MiB;
constexpr size_t WS_RIDX = 4 * MiB;
constexpr size_t WS_RW = WS_RIDX + 512 * 1024;
constexpr size_t WS_RPOS = WS_RW + 512 * 1024;
constexpr size_t WS_SEGCNT = 6 * MiB;
constexpr size_t WS_FLOG = 8 * MiB;
constexpr size_t WS_WSMALL = 16 * MiB, WSMALL_LAYER = 19 * MiB;
constexpr size_t WS_W13 = 64 * MiB;
constexpr size_t WS_W2 = 192 * MiB;
constexpr size_t WS_U = 256 * MiB;
constexpr size_t WS_Z = 320 * MiB;
constexpr size_t WS_G = 592 * MiB;
constexpr size_t WS_ACT = 768 * MiB;
constexpr size_t WS_HOUT = 864 * MiB;
constexpr size_t WS_U2 = 928 * MiB;
constexpr size_t WS_XS = 256 * MiB;
constexpr size_t WS_H = 520 * MiB;
constexpr size_t WS_END = 1056 * MiB;
static_assert(WS_XS + (size_t)PMAX * 1024 * 2 <= WS_H && WS_H + (size_t)PMAX * 2048 * 2 <= WS_END && WS_U2 + (size_t)T * D * 2 <= WS_END, "ws map");
static_assert(WS_HOUT + (size_t)TH * D * 2 <= WS_U2 && WS_ACT + (size_t)TH * ACTC * 2 <= WS_HOUT && WS_G + (size_t)TH * GP <= WS_ACT && WS_Z + (size_t)TH * ZP * 2 <= WS_G, "ws map 2");
constexpr size_t WS_UF8_H1 = WS_U2 + 64 * MiB;
static_assert(WS_UF8_H1 + (size_t)TH * D <= WS_END, "ws map 3");
constexpr int CW_BAR = 4096;
constexpr int CW_QUEUE = 8192;

constexpr int RING_BYTES = 131072;
constexpr int LDSCTL_OFF = RING_BYTES, MISC_OFF = LDSCTL_OFF + 320;
constexpr int PEXP_OFF = LDSCTL_OFF + 1024;
constexpr int HIST_OFF = LDSCTL_OFF + 4096;
constexpr int LDS_BYTES = 147456;
constexpr int NWAVES = 8;

typedef float pk_f32x2_t __attribute__((ext_vector_type(2))); typedef __bf16 pk_bf16x2_t __attribute__((ext_vector_type(2)));
__device__ __forceinline__ unsigned pk2(float lo, float hi) { const pk_f32x2_t v = {lo, hi}; const pk_bf16x2_t b = __builtin_convertvector(v, pk_bf16x2_t); return __builtin_bit_cast(unsigned, b); }
__device__ __forceinline__ unsigned f2bf(float f) { return pk2(f, 0.f) & 0xffffu; }
__device__ __forceinline__ float bflo(unsigned w) { return __uint_as_float(w << 16); }
__device__ __forceinline__ float bfhi(unsigned w) { return __uint_as_float(w & 0xffff0000u); }
__device__ __forceinline__ float sigm(float x) { return __builtin_amdgcn_rcpf(1.f + __builtin_amdgcn_exp2f(-1.4426950408889634f * x)); }
#define SWZ_XOR(o) (0x1f | ((o) << 10))
__device__ __forceinline__ float swz_xor1(float v)  { return __int_as_float(__builtin_amdgcn_ds_swizzle(__float_as_int(v), SWZ_XOR(1))); }
__device__ __forceinline__ float swz_xor2(float v)  { return __int_as_float(__builtin_amdgcn_ds_swizzle(__float_as_int(v), SWZ_XOR(2))); }
__device__ __forceinline__ float swz_xor4(float v)  { return __int_as_float(__builtin_amdgcn_ds_swizzle(__float_as_int(v), SWZ_XOR(4))); }
__device__ __forceinline__ float swz_xor8(float v)  { return __int_as_float(__builtin_amdgcn_ds_swizzle(__float_as_int(v), SWZ_XOR(8))); }
__device__ __forceinline__ float swz_xor16(float v) { return __int_as_float(__builtin_amdgcn_ds_swizzle(__float_as_int(v), SWZ_XOR(16))); }
__device__ __forceinline__ float sum_xor32(float v) { auto rr = __builtin_amdgcn_permlane32_swap(__float_as_uint(v), __float_as_uint(v), false, false); return __uint_as_float(rr[0]) + __uint_as_float(rr[1]); }
__device__ __forceinline__ float max_xor32(float v) { auto rr = __builtin_amdgcn_permlane32_swap(__float_as_uint(v), __float_as_uint(v), false, false); return fmaxf(__uint_as_float(rr[0]), __uint_as_float(rr[1])); }
__device__ __forceinline__ float wave_sum(float v) {
    v += swz_xor1(v); v += swz_xor2(v); v += swz_xor4(v); v += swz_xor8(v); v += swz_xor16(v); return sum_xor32(v);
}
template <int N> __device__ __forceinline__ void wave_sum_n(float (&v)[N]) {
    float t[N];
#pragma unroll
    for (int i = 0; i < N; ++i) t[i] = swz_xor1(v[i]);
#pragma unroll
    for (int i = 0; i < N; ++i) v[i] += t[i];
#pragma unroll
    for (int i = 0; i < N; ++i) t[i] = swz_xor2(v[i]);
#pragma unroll
    for (int i = 0; i < N; ++i) v[i] += t[i];
#pragma unroll
    for (int i = 0; i < N; ++i) t[i] = swz_xor4(v[i]);
#pragma unroll
    for (int i = 0; i < N; ++i) v[i] += t[i];
#pragma unroll
    for (int i = 0; i < N; ++i) t[i] = swz_xor8(v[i]);
#pragma unroll
    for (int i = 0; i < N; ++i) v[i] += t[i];
#pragma unroll
    for (int i = 0; i < N; ++i) t[i] = swz_xor16(v[i]);
#pragma unroll
    for (int i = 0; i < N; ++i) v[i] += t[i];
#pragma unroll
    for (int i = 0; i < N; ++i) v[i] = sum_xor32(v[i]);
}
__device__ __forceinline__ float rs16(const float (&v)[16], int lane) {
    float a[8];
#pragma unroll
    for (int i = 0; i < 8; ++i) { auto rr = __builtin_amdgcn_permlane32_swap(__float_as_uint(v[i]), __float_as_uint(v[8 + i]), false, false);
        a[i] = __uint_as_float(rr[0]) + __uint_as_float(rr[1]); }
    const bool b4 = (lane & 16) != 0, b3 = (lane & 8) != 0, b2 = (lane & 4) != 0;
    float b[4];
#pragma unroll
    for (int i = 0; i < 4; ++i) { const float mine = b4 ? a[4 + i] : a[i], other = b4 ? a[i] : a[4 + i]; b[i] = mine + swz_xor16(other); }
    float c[2];
#pragma unroll
    for (int i = 0; i < 2; ++i) { const float mine = b3 ? b[2 + i] : b[i], other = b3 ? b[i] : b[2 + i]; c[i] = mine + swz_xor8(other); }
    float d = (b2 ? c[1] : c[0]) + swz_xor4(b2 ? c[0] : c[1]);
    d += swz_xor1(d); d += swz_xor2(d);
    return d;
}
__device__ __forceinline__ float lane_bcast(float x, int srclane) { return __int_as_float(__builtin_amdgcn_readlane(__float_as_int(x), srclane)); }
__device__ __forceinline__ int opaque_v(int x) { asm volatile("" : "+v"(x)); return x; }
__device__ __forceinline__ int opaque_s(int x) { asm volatile("" : "+s"(x)); return x; }
typedef int i32x8 __attribute__((ext_vector_type(8)));
__device__ __forceinline__ f32x4 bf4_to_f32(u32x2 p) { return (f32x4){bflo(p.x), bfhi(p.x), bflo(p.y), bfhi(p.y)}; }
__device__ __forceinline__ unsigned pk4_fp8(float a, float b, float c, float d) {
    a = __builtin_amdgcn_fmed3f(a, -448.f, 448.f); b = __builtin_amdgcn_fmed3f(b, -448.f, 448.f); c = __builtin_amdgcn_fmed3f(c, -448.f, 448.f); d = __builtin_amdgcn_fmed3f(d, -448.f, 448.f);
    int r = 0; r = __builtin_amdgcn_cvt_pk_fp8_f32(a, b, r, false); r = __builtin_amdgcn_cvt_pk_fp8_f32(c, d, r, true); return (unsigned)r; }
__device__ __forceinline__ unsigned pk4_fp8_nc(float a, float b, float c, float d) { int r = 0; r = __builtin_amdgcn_cvt_pk_fp8_f32(a, b, r, false); r = __builtin_amdgcn_cvt_pk_fp8_f32(c, d, r, true); return (unsigned)r; }
constexpr float FP8_SX = 16.f, FP8_SH = 16.f, FP8_SW13 = 64.f, FP8_SW2 = 128.f, FP8_SY = 64.f, FP8_SG = 256.f;
#define LDS_WAIT() asm volatile("s_waitcnt lgkmcnt(0)" ::: "memory")
#define VM_WAIT() asm volatile("s_waitcnt vmcnt(0)" ::: "memory")
#define LDS_BARRIER() do { asm volatile("s_waitcnt lgkmcnt(0)" ::: "memory"); __builtin_amdgcn_s_barrier(); asm volatile("" ::: "memory"); } while (0)
#define RLX_AGENT __ATOMIC_RELAXED, __HIP_MEMORY_SCOPE_AGENT

namespace pg8 {
constexpr int BM = 256, BK = 64, HALF = 128, HTB = HALF * BK * 2, STAGE_BYTES = 8 * HTB, NXCD = 8, WGM = 8;
__host__ __device__ __forceinline__ int lds_byte(int r, int c) { const int st = (r >> 4) * 2 + (c >> 5), rr = r & 15, cc = c & 31, ob = rr * 64 + cc * 2; return st * 1024 + (ob ^ (((ob >> 9) & 1) << 5)); }
__host__ __device__ __forceinline__ void stage_rc(int b, int& R, int& C) { const int st = b / 1024, sb = b % 1024, swz = sb ^ (((sb >> 9) & 1) << 5); R = (st >> 1) * 16 + swz / 64; C = (st & 1) * 32 + (swz % 64) / 2; }
__host__ __device__ __forceinline__ int perm32(int rho) { const int n = rho >> 4, i = rho & 15; return 8 * (i >> 2) + 4 * n + (i & 3); }

typedef int i32x4_t __attribute__((ext_vector_type(4)));
struct Unit { int pm, pn, e; };
struct Gemm { const bf16_t* A; const bf16_t* Bt; int K; size_t bstride; };

struct StaticOrder {
    int nM, nN, nwg, G, c; int pn_off = 0;
    __device__ void init(int M, int N, int G_, int c_) { nM = M / BM; nN = N / BM; nwg = nM * nN; G = G_; c = c_; }
    __device__ bool next(int i, Unit& u) const {
        const long L = (long)i * G + c; if (L >= nwg) return false;
        int wgid = (int)L; { const int q = nwg / NXCD, r = nwg % NXCD, xcd = wgid % NXCD, off = wgid / NXCD; wgid = (xcd < r ? xcd * (q + 1) : r * (q + 1) + (xcd - r) * q) + off; }
        const int nig = WGM * nN, gid = wgid / nig, fm = gid * WGM, gsz = (nM - fm) < WGM ? (nM - fm) : WGM;
        u.pm = fm + ((wgid % nig) % gsz); u.pn = (wgid % nig) / gsz + pn_off; u.e = 0; return true;
    }
};
struct MoeOrder {
    int nN, G, c, np; const LAS int* pexp; int PG, NG;
    __device__ bool next(int i, Unit& u) const {
        const int xcd = c & 7, k = c >> 3, R = i * 8 + xcd, ngrp = nN / NG, s_ = R / ngrp, pg = R % ngrp;
        const int panel = s_ * PG + (k % PG); if (panel >= np) return false;
        u.pm = panel; u.pn = pg * NG + (k / PG); u.e = __builtin_amdgcn_readfirstlane(pexp[u.pm]); return true;
    }
};

__device__ __forceinline__ unsigned cvt_pk_bf16(float lo, float hi) { unsigned r; asm volatile("v_cvt_pk_bf16_f32 %0, %1, %2" : "=v"(r) : "v"(lo), "v"(hi)); return r; }

struct EpiZG {
    static constexpr bool PERM = true, HOOK = false;
    bf16_t* Z; bf16_t* Gt; const float* bgate; int pn_add; float ginv;
    __device__ __forceinline__ void operator()(const f32x4 (&acc)[2][2][4][2], const Unit& u, int wr, int wc, int fr, int fq) const {
        const int upn = u.pn + pn_add;
        const bool isg = upn >= 16; const float qsc = (upn == 10 || upn == 11) ? 0.125f * 1.4426950408889634f : 1.f;
        const int row0 = u.pm * BM + wr * 64 + fr; const int colt = (isg ? upn - 16 : upn) * BM;
        const int col0 = colt + wc * 32 + 8 * fq;
        f32x4 bv[2][2];
#pragma unroll
        for (int bj = 0; bj < 2; ++bj)
#pragma unroll
            for (int n = 0; n < 2; ++n) bv[bj][n] = isg ? *(const f32x4*)(bgate + col0 + bj * HALF + 4 * n) : (f32x4){0.f, 0.f, 0.f, 0.f};
#pragma unroll
        for (int ai = 0; ai < 2; ++ai)
#pragma unroll
            for (int m = 0; m < 4; ++m) { const size_t row = (size_t)(row0 + ai * HALF + m * 16);
#pragma unroll
                for (int bj = 0; bj < 2; ++bj) { f32x4 v0 = acc[ai][bj][m][0], v1 = acc[ai][bj][m][1];
                    if (isg) { v0 = v0 * ginv + bv[bj][0]; v1 = v1 * ginv + bv[bj][1];
#pragma unroll
                        for (int q = 0; q < 4; ++q) { v0[q] = fmaxf(sigm(v0[q]) * FP8_SG, 0.002f); v1[q] = fmaxf(sigm(v1[q]) * FP8_SG, 0.002f); }
                        *(u32x2*)((unsigned char*)Gt + row * GP + col0 + bj * HALF) = (u32x2){pk4_fp8_nc(v0[0], v0[1], v0[2], v0[3]), pk4_fp8_nc(v1[0], v1[1], v1[2], v1[3])}; }
                    else { v0 = v0 * (qsc * ginv); v1 = v1 * (qsc * ginv);
                        u32x4 w; w.x = cvt_pk_bf16(v0[0], v0[1]); w.y = cvt_pk_bf16(v0[2], v0[3]); w.z = cvt_pk_bf16(v1[0], v1[1]); w.w = cvt_pk_bf16(v1[2], v1[3]);
                        *(u32x4*)(Z + row * ZP + col0 + bj * HALF) = w; } } }
    }
};
struct EpiBf16 {
    static constexpr bool PERM = true, HOOK = false;
    bf16_t* O; int ldc; float scale; int fp8out;
    __device__ __forceinline__ void operator()(const f32x4 (&acc)[2][2][4][2], const Unit& u, int wr, int wc, int fr, int fq) const {
        const int row0 = u.pm * BM + wr * 64 + fr; const int col0 = u.pn * BM + wc * 32 + 8 * fq;
        if (fp8out) {
#pragma unroll
            for (int ai = 0; ai < 2; ++ai)
#pragma unroll
                for (int m = 0; m < 4; ++m) { unsigned char* rowp = (unsigned char*)O + (size_t)(row0 + ai * HALF + m * 16) * ldc + col0;
#pragma unroll
                    for (int bj = 0; bj < 2; ++bj) { const f32x4 v0 = acc[ai][bj][m][0] * scale, v1 = acc[ai][bj][m][1] * scale;
                        *(u32x2*)(rowp + bj * HALF) = (u32x2){pk4_fp8(v0[0], v0[1], v0[2], v0[3]), pk4_fp8(v1[0], v1[1], v1[2], v1[3])}; } }
            return; }
#pragma unroll
        for (int ai = 0; ai < 2; ++ai)
#pragma unroll
            for (int m = 0; m < 4; ++m) { bf16_t* rowp = O + (size_t)(row0 + ai * HALF + m * 16) * ldc + col0;
#pragma unroll
                for (int bj = 0; bj < 2; ++bj) { const f32x4 v0 = acc[ai][bj][m][0] * scale, v1 = acc[ai][bj][m][1] * scale;
                    u32x4 w; w.x = cvt_pk_bf16(v0[0], v0[1]); w.y = cvt_pk_bf16(v0[2], v0[3]); w.z = cvt_pk_bf16(v1[0], v1[1]); w.w = cvt_pk_bf16(v1[2], v1[3]);
                    *(u32x4*)(rowp + bj * HALF) = w; } }
    }
};
struct EpiSwiGLU {
    static constexpr bool PERM = true, HOOK = false;
    unsigned char* Hb;
    __device__ __forceinline__ void operator()(const f32x4 (&acc)[2][2][4][2], const Unit& u, int wr, int wc, int fr, int fq) const {
        const int row0 = u.pm * BM + wr * 64 + fr; const int col0 = u.pn * HALF + wc * 32 + 8 * fq;
        constexpr float INV = 1.f / (FP8_SX * FP8_SW13);
#pragma unroll
        for (int ai = 0; ai < 2; ++ai)
#pragma unroll
            for (int m = 0; m < 4; ++m) { unsigned char* rowp = Hb + (size_t)(row0 + ai * HALF + m * 16) * FF + col0;
                f32x4 v0 = acc[ai][0][m][0] * INV, v1 = acc[ai][0][m][1] * INV; const f32x4 g0 = acc[ai][1][m][0] * (INV * FP8_SH), g1 = acc[ai][1][m][1] * (INV * FP8_SH);
#pragma unroll
                for (int q = 0; q < 4; ++q) { v0[q] = v0[q] * sigm(v0[q]) * g0[q]; v1[q] = v1[q] * sigm(v1[q]) * g1[q]; }
                *(u32x2*)rowp = (u32x2){pk4_fp8(v0[0], v0[1], v0[2], v0[3]), pk4_fp8(v1[0], v1[1], v1[2], v1[3])}; }
    }
};
struct EpiMerge {
    static constexpr bool PERM = true, HOOK = true;
    const unsigned char* Gb; bf16_t* Mo;
    __device__ __forceinline__ void hook(f32x4 (&acc)[2][2][4][2], const Unit& u, int j, int wr, int wc, int fr, int fq) const {
        const int row0 = opaque_v(u.pm * BM + wr * 64 + fr); const int col0 = opaque_v(u.pn * BM + wc * 32 + 8 * fq);
#pragma unroll
        for (int ai = 0; ai < 2; ++ai) {
            u32x2 ga[4][2], gb[4][2];
#pragma unroll
            for (int m = 0; m < 4; ++m)
#pragma unroll
                for (int bj = 0; bj < 2; ++bj) { const unsigned char* p = Gb + (size_t)(row0 + ai * HALF + m * 16) * GP + col0 + bj * HALF;
                    ga[m][bj] = *(const u32x2*)(p + (j - 1) * D); gb[m][bj] = *(const u32x2*)(p + j * D); }
#pragma unroll
            for (int m = 0; m < 4; ++m)
#pragma unroll
                for (int bj = 0; bj < 2; ++bj) {
#pragma unroll
                    for (int q = 0; q < 2; ++q) { const int a = (int)ga[m][bj][q], b = (int)gb[m][bj][q];
                        const f32x2 alo = __builtin_amdgcn_cvt_pk_f32_fp8(a, false), ahi = __builtin_amdgcn_cvt_pk_f32_fp8(a, true), blo = __builtin_amdgcn_cvt_pk_f32_fp8(b, false), bhi = __builtin_amdgcn_cvt_pk_f32_fp8(b, true);
                        acc[ai][bj][m][q][0] *= alo.x * __builtin_amdgcn_rcpf(blo.x); acc[ai][bj][m][q][1] *= alo.y * __builtin_amdgcn_rcpf(blo.y);
                        acc[ai][bj][m][q][2] *= ahi.x * __builtin_amdgcn_rcpf(bhi.x); acc[ai][bj][m][q][3] *= ahi.y * __builtin_amdgcn_rcpf(bhi.y); } }
            asm volatile("" ::: "memory");
        }
    }
    __device__ __forceinline__ void operator()(const f32x4 (&acc)[2][2][4][2], const Unit& u, int wr, int wc, int fr, int fq) const {
        const int row0 = u.pm * BM + wr * 64 + fr; const int col0 = u.pn * BM + wc * 32 + 8 * fq;
        constexpr float IG = FP8_SX / FP8_SG;
#pragma unroll
        for (int ai = 0; ai < 2; ++ai) {
            u32x2 gc[4][2];
#pragma unroll
            for (int m = 0; m < 4; ++m)
#pragma unroll
                for (int bj = 0; bj < 2; ++bj) gc[m][bj] = *(const u32x2*)(Gb + (size_t)(row0 + ai * HALF + m * 16) * GP + 2 * D + col0 + bj * HALF);
#pragma unroll
            for (int m = 0; m < 4; ++m)
#pragma unroll
                for (int bj = 0; bj < 2; ++bj) { const f32x4 v0 = acc[ai][bj][m][0] * IG, v1 = acc[ai][bj][m][1] * IG;
                    const f32x2 g0 = __builtin_amdgcn_cvt_pk_f32_fp8((int)gc[m][bj].x, false), g1 = __builtin_amdgcn_cvt_pk_f32_fp8((int)gc[m][bj].x, true), g2 = __builtin_amdgcn_cvt_pk_f32_fp8((int)gc[m][bj].y, false), g3 = __builtin_amdgcn_cvt_pk_f32_fp8((int)gc[m][bj].y, true);
                    *(u32x2*)((unsigned char*)Mo + (size_t)(row0 + ai * HALF + m * 16) * D + col0 + bj * HALF) = (u32x2){pk4_fp8(v0[0] * g0.x, v0[1] * g0.y, v0[2] * g1.x, v0[3] * g1.y), pk4_fp8(v1[0] * g2.x, v1[1] * g2.y, v1[2] * g3.x, v1[3] * g3.y)}; }
        }
    }
};

template <class Epi, class Sched, bool FP8 = false>
__device__ __forceinline__ void gemm_phase(LAS unsigned char* lds, const int tid_, const Gemm g, const Sched& S, const Epi& E) {
    const int tid = opaque_v(tid_), wid = __builtin_amdgcn_readfirstlane(tid >> 6), lane = tid & 63, wr = wid >> 2, wc = wid & 3, fr = lane & 15, fq = lane >> 4;
    const int K = g.K, nt = K / BK;
    unsigned voffA[2], voffB[2];
#pragma unroll
    for (int i = 0; i < 2; ++i) { int R, C; stage_rc(tid * 16 + i * 8192, R, C); const int Rb = Epi::PERM ? ((R & ~31) + perm32(R & 31)) : R;
        voffA[i] = (unsigned)(R * K + C) * 2u; voffB[i] = (unsigned)(Rb * K + C) * 2u; }
    const size_t kstep = (size_t)(BK * 2);
    const size_t hstep = (size_t)HALF * K * 2;
    const size_t tstep = 2 * hstep;
    const unsigned ldsw = (unsigned)wid * 1024u;
    const int aoff = lds_byte(wr * 64 + fr, fq * 8), boff = lds_byte(wc * 32 + fr, fq * 8);
#define PG8_SA(b, h) (((b) * 2 + (h)) * HTB)
#define PG8_SB(b, h) ((4 + (b) * 2 + (h)) * HTB)
#define PG8_STAGE(bufoff, gbase, voff) do { _Pragma("unroll") for (int _i = 0; _i < 2; ++_i) \
        __builtin_amdgcn_global_load_lds((const unsigned*)((const char*)(gbase) + (voff)[_i]), (LAS unsigned*)(lds + (bufoff) + ldsw + _i * 8192), 16, 0, 0); } while (0)
#define PG8_LDA(dst, b, h) do { _Pragma("unroll") for (int m = 0; m < 4; ++m) _Pragma("unroll") for (int k = 0; k < 2; ++k) dst[m][k] = *(const LAS bf16x8*)(lds + PG8_SA(b, h) + aoff + m * 2048 + k * 1024); } while (0)
#define PG8_LDB(dst, b, h) do { _Pragma("unroll") for (int n = 0; n < 2; ++n) _Pragma("unroll") for (int k = 0; k < 2; ++k) dst[n][k] = *(const LAS bf16x8*)(lds + PG8_SB(b, h) + boff + n * 2048 + k * 1024); } while (0)
#define PG8_CAT(lo, hi) __builtin_shufflevector(__builtin_bit_cast(i32x4_t, lo), __builtin_bit_cast(i32x4_t, hi), 0, 1, 2, 3, 4, 5, 6, 7)
#define PG8_MMA(ai, bj, At, Bt) do { __builtin_amdgcn_s_setprio(1); _Pragma("unroll") for (int m = 0; m < 4; ++m) _Pragma("unroll") for (int n = 0; n < 2; ++n) { \
        if constexpr (FP8) { const i32x8 b8_ = PG8_CAT(Bt[n][0], Bt[n][1]), a8_ = PG8_CAT(At[m][0], At[m][1]); asm volatile("v_mfma_f32_16x16x128_f8f6f4 %0, %1, %2, %0" : "+v"(acc[ai][bj][m][n]) : "v"(b8_), "v"(a8_)); } \
        else { _Pragma("unroll") for (int k = 0; k < 2; ++k) acc[ai][bj][m][n] = __builtin_amdgcn_mfma_f32_16x16x32_bf16(Bt[n][k], At[m][k], acc[ai][bj][m][n], 0, 0, 0); } } __builtin_amdgcn_s_setprio(0); } while (0)
#define PG8_WAIT_V(n) asm volatile("s_waitcnt vmcnt(" #n ")" ::: "memory")
#define PG8_WAIT_L(n) asm volatile("s_waitcnt lgkmcnt(" #n ")" ::: "memory")
#define PG8_BAR __builtin_amdgcn_s_barrier()
#define PG8_SCHED __builtin_amdgcn_sched_barrier(0)
    Unit cur, nxt; int ui = 0;
    if (!S.next(0, cur)) return;
    f32x4 acc[2][2][4][2];
#pragma unroll
    for (int a = 0; a < 2; ++a)
#pragma unroll
        for (int b = 0; b < 2; ++b)
#pragma unroll
            for (int m = 0; m < 4; ++m)
#pragma unroll
                for (int n = 0; n < 2; ++n) acc[a][b][m][n] = (f32x4){0.f, 0.f, 0.f, 0.f};
    bf16x8 At[4][2], B0[2][2], B1[2][2];
    const char* cA = (const char*)g.A + (size_t)cur.pm * tstep; const char* cB = (const char*)g.Bt + (size_t)cur.e * g.bstride + (size_t)cur.pn * tstep;
    PG8_STAGE(PG8_SB(0, 0), cB, voffB); PG8_STAGE(PG8_SB(0, 1), cB + hstep, voffB); PG8_STAGE(PG8_SA(0, 0), cA, voffA); PG8_STAGE(PG8_SA(0, 1), cA + hstep, voffA);
    if (wr == 1) PG8_BAR;
    PG8_WAIT_V(2); PG8_BAR;
    PG8_STAGE(PG8_SB(1, 0), cB + kstep, voffB); PG8_STAGE(PG8_SA(1, 0), cA + kstep, voffA); PG8_STAGE(PG8_SB(1, 1), cB + hstep + kstep, voffB);
    PG8_WAIT_V(6); PG8_BAR;
    for (;;) {
        const bool has_next = S.next(ui + 1, nxt);
        const char* nA = has_next ? (const char*)g.A + (size_t)nxt.pm * tstep : cA;
        const char* nB = has_next ? (const char*)g.Bt + (size_t)nxt.e * g.bstride + (size_t)nxt.pn * tstep : cB;
        for (int t = 0; t < nt; t += 2) {
            if constexpr (Epi::HOOK) { if (t == 8 || t == 16) { E.hook(acc, cur, t >> 3, wr, wc, fr, fq); } }
            const bool last = (t == nt - 2);
            const char* a1 = cA + (size_t)(t + 1) * kstep;
            const char* a2 = last ? nA : cA + (size_t)(t + 2) * kstep; const char* b2 = last ? nB : cB + (size_t)(t + 2) * kstep;
            const char* a3 = a2 + kstep; const char* b3 = b2 + kstep;
            PG8_LDB(B0, 0, 0); PG8_LDB(B1, 0, 1); PG8_SCHED; PG8_LDA(At, 0, 0); PG8_STAGE(PG8_SA(1, 1), a1 + hstep, voffA);
            PG8_WAIT_V(8); PG8_WAIT_L(0); PG8_BAR; PG8_MMA(0, 0, At, B0); PG8_MMA(0, 1, At, B1); PG8_BAR; PG8_SCHED;
            PG8_LDA(At, 0, 1); PG8_STAGE(PG8_SB(0, 0), b2, voffB); PG8_STAGE(PG8_SB(0, 1), b2 + hstep, voffB); PG8_STAGE(PG8_SA(0, 0), a2, voffA);
            PG8_WAIT_V(8); PG8_WAIT_L(0); PG8_BAR; PG8_MMA(1, 0, At, B0); PG8_MMA(1, 1, At, B1); PG8_BAR; PG8_SCHED;
            PG8_LDB(B0, 1, 0); PG8_LDB(B1, 1, 1); PG8_SCHED; PG8_LDA(At, 1, 0); PG8_STAGE(PG8_SA(0, 1), a2 + hstep, voffA);
            PG8_WAIT_V(8); PG8_WAIT_L(0); PG8_BAR; PG8_MMA(0, 0, At, B0); PG8_MMA(0, 1, At, B1); PG8_BAR; PG8_SCHED;
            PG8_LDA(At, 1, 1); PG8_STAGE(PG8_SB(1, 0), b3, voffB); PG8_STAGE(PG8_SB(1, 1), b3 + hstep, voffB); PG8_STAGE(PG8_SA(1, 0), a3, voffA);
            PG8_WAIT_V(8); PG8_WAIT_L(0); PG8_BAR; PG8_MMA(1, 0, At, B0); PG8_MMA(1, 1, At, B1); PG8_BAR; PG8_SCHED;
        }
        if constexpr (FP8) {
#define PG8_ACC4(a, b, m) "+v"(acc[a][b][m][0]), "+v"(acc[a][b][m][1])
            asm volatile("s_nop 15\n\ts_nop 7" : PG8_ACC4(0, 0, 0), PG8_ACC4(0, 0, 1), PG8_ACC4(0, 0, 2), PG8_ACC4(0, 0, 3), PG8_ACC4(0, 1, 0), PG8_ACC4(0, 1, 1), PG8_ACC4(0, 1, 2), PG8_ACC4(0, 1, 3) :: "memory");
            asm volatile("" : PG8_ACC4(1, 0, 0), PG8_ACC4(1, 0, 1), PG8_ACC4(1, 0, 2), PG8_ACC4(1, 0, 3), PG8_ACC4(1, 1, 0), PG8_ACC4(1, 1, 1), PG8_ACC4(1, 1, 2), PG8_ACC4(1, 1, 3) :: "memory");
#undef PG8_ACC4
        }
        if (wr == 0) PG8_BAR;
        E(acc, cur, wr, wc, fr, fq);
        if (!has_next) break;
#pragma unroll
        for (int a = 0; a < 2; ++a)
#pragma unroll
            for (int b = 0; b < 2; ++b)
#pragma unroll
                for (int m = 0; m < 4; ++m)
#pragma unroll
                    for (int n = 0; n < 2; ++n) acc[a][b][m][n] = (f32x4){0.f, 0.f, 0.f, 0.f};
        cur = nxt; cA = nA; cB = nB; ++ui;
        if (wr == 1) PG8_BAR;
    }
    PG8_WAIT_V(0);
    PG8_BAR;
#undef PG8_SA
#undef PG8_SB
#undef PG8_STAGE
#undef PG8_LDA
#undef PG8_LDB
#undef PG8_MMA
#undef PG8_CAT
#undef PG8_WAIT_V
#undef PG8_WAIT_L
#undef PG8_BAR
#undef PG8_SCHED
}
}

#define XB_TMO      128
#define XB_XCNT(j)  (256  + 64 * (j))
#define XB_XSUB(j)  (1280 + 64 * (j))
#define XB_XGEN(j)  (2304 + 64 * (j))
#define XB_TOP      3328
#define XB_TOPGEN   3392
#define XCD_BAR_WORDS 3456
#define XB_SPIN_CAP (1u << 18)
__device__ __forceinline__ unsigned xb_ld(unsigned* p)              { return __hip_atomic_load(p, __ATOMIC_RELAXED, __HIP_MEMORY_SCOPE_AGENT); }
__device__ __forceinline__ unsigned xb_add(unsigned* p, unsigned v) { return __hip_atomic_fetch_add(p, v, __ATOMIC_RELAXED, __HIP_MEMORY_SCOPE_AGENT); }
__device__ __forceinline__ unsigned xb_xcc_id() { return (unsigned)__builtin_amdgcn_s_getreg((3 << 11) | 20) & 0xFu; }
#define XB_SPIN(cond, bar) do { unsigned _sp = 0; while (cond) { __builtin_amdgcn_s_sleep(1); \
    if ((++_sp & 255u) == 0u) { if (xb_ld(&(bar)[XB_TMO])) break; if (_sp > XB_SPIN_CAP) { atomicAdd(&(bar)[XB_TMO], 1u); break; } } } } while (0)
struct XcdBarrier { unsigned* bar; unsigned x; volatile LAS unsigned* st; };
__device__ __forceinline__ XcdBarrier xcd_barrier_post(unsigned* bar, volatile LAS unsigned* st, const bool t0  ) {
    XcdBarrier b; b.bar = bar; b.x = xb_xcc_id(); b.st = st;
    if (t0) (void)xb_add(&bar[XB_XCNT(b.x)], 1u);
    return b;
}
__device__ __forceinline__ void xcd_barrier_complete(unsigned* bar, unsigned x, unsigned& nloc, unsigned& nx) {
    const unsigned G = gridDim.x * gridDim.y * gridDim.z;
    unsigned sum, cnt, mine, sp = 0u;
    for (;;) {
        sum = 0u; cnt = 0u; mine = 0u;
#pragma unroll
        for (unsigned j = 0; j < 16; ++j) { const unsigned c = xb_ld(&bar[XB_XCNT(j)]); sum += c; cnt += (c > 0u) ? 1u : 0u; mine = (j == x) ? c : mine; }
        if (sum == G) break;
        __builtin_amdgcn_s_sleep(1);
        if ((++sp & 255u) == 0u) { if (xb_ld(&bar[XB_TMO])) break; if (sp > XB_SPIN_CAP) { atomicAdd(&bar[XB_TMO], 1u); break; } }
    }
    nloc = mine > 0u ? mine : 1u; nx = cnt > 0u ? cnt : 1u;
}
__device__ __forceinline__ void xcd_barrier(const XcdBarrier& b, const bool t0  ) {
    asm volatile("s_waitcnt vmcnt(0)" ::: "memory");
    __syncthreads();
    if (t0) {
        unsigned* bar = b.bar; asm volatile("" : "+s"(bar));
        __builtin_amdgcn_s_waitcnt(0);
        unsigned nloc = b.st[0], nx = b.st[1];
        if (nloc == 0u) { xcd_barrier_complete(bar, b.x, nloc, nx); b.st[0] = nloc; b.st[1] = nx; }
        const unsigned old = xb_add(&bar[XB_XSUB(b.x)], 1u);
        const unsigned gen = old / nloc;
        if (old + 1u == (gen + 1u) * nloc) {
            __builtin_amdgcn_fence(__ATOMIC_RELEASE, "agent");
            asm volatile("s_waitcnt vmcnt(0)" ::: "memory");
            const unsigned og = xb_add(&bar[XB_TOP], 1u);
            const unsigned tg = og / nx;
            if (og + 1u == (tg + 1u) * nx) xb_add(&bar[XB_TOPGEN], 1u);
            else XB_SPIN(xb_ld(&bar[XB_TOPGEN]) == tg, bar);
            __builtin_amdgcn_fence(__ATOMIC_ACQUIRE, "agent");
            xb_add(&bar[XB_XGEN(b.x)], 1u);
            asm volatile("s_waitcnt vmcnt(0)" ::: "memory");
        } else {
            XB_SPIN(xb_ld(&bar[XB_XGEN(b.x)]) == gen, bar);
            __builtin_amdgcn_fence(__ATOMIC_ACQUIRE, "agent");
            asm volatile("s_waitcnt vmcnt(0)" ::: "memory");
        }
    }
    __syncthreads();
}

struct Args { const float* in[25]; float* out; unsigned char* ws; int ph_lo, ph_hi; };
constexpr int PTAB_OFF = LDSCTL_OFF + 512;
struct InTab { const LAS unsigned long long* p;
    __device__ __forceinline__ const float* operator[](int i) const { const unsigned long long v = p[i];
        const unsigned lo = __builtin_amdgcn_readfirstlane((unsigned)v), hi = __builtin_amdgcn_readfirstlane((unsigned)(v >> 32)); return (const float*)(const GAS float*)(((unsigned long long)hi << 32) | lo); } };
struct Frame {
    LAS unsigned char* lds;
    int tid, lane, wave, G, bid;
    InTab in;
    __device__ __forceinline__ float* outp() const { return (float*)in[25]; }
    __device__ __forceinline__ unsigned char* wsp() const { return (unsigned char*)in[26]; }
};
enum { I_X = 0, I_C, I_WADA, I_BADA, I_WIN, I_CONVW, I_CONVB, I_CLNG, I_CLNB, I_BFORGET, I_WCONVOUT, I_WRETOUT, I_WFOXOUT, I_WGATE, I_BGATE, I_WOUT, I_LN1G, I_LN1B,
       I_WROUTER, I_BROUTER, I_W1, I_W3, I_W2, I_LN2G, I_LN2B };

__device__ __forceinline__ void transpose_item(const float* W, int ldw, int k0, int n0, bf16_t* dst, int dpitch, int drow0, int dk0, LAS float* scr, int lane) {
#pragma unroll 8
    for (int i = 0; i < 32; ++i) { const int kk = 2 * i + (lane >> 5); scr[kk * 33 + (lane & 31)] = W[(size_t)(k0 + kk) * ldw + n0 + (lane & 31)]; }
    LDS_WAIT(); asm volatile("" ::: "memory");
    const int c = lane & 7;
#pragma unroll
    for (int j = 0; j < 4; ++j) { const int n = (lane >> 3) + 8 * j; const LAS float* s = scr + (8 * c) * 33 + n;
        u32x4 o; o.x = pk2(s[0 * 33], s[1 * 33]); o.y = pk2(s[2 * 33], s[3 * 33]); o.z = pk2(s[4 * 33], s[5 * 33]); o.w = pk2(s[6 * 33], s[7 * 33]);
        *(u32x4*)(dst + (size_t)(drow0 + n) * dpitch + dk0 + k0 + 8 * c) = o; }
    LDS_WAIT(); asm volatile("" ::: "memory");
}
__device__ __forceinline__ void transpose_item_fp8(const float* W, int ldw, int k0, int n0, unsigned char* dst, int dpitch, int drow0, int dk0, LAS float* scr, int lane, float scale) {
#pragma unroll 8
    for (int i = 0; i < 32; ++i) { const int kk = 2 * i + (lane >> 5); scr[kk * 33 + (lane & 31)] = W[(size_t)(k0 + kk) * ldw + n0 + (lane & 31)]; }
    LDS_WAIT(); asm volatile("" ::: "memory");
    const int c = lane & 7;
#pragma unroll
    for (int j = 0; j < 4; ++j) { const int n = (lane >> 3) + 8 * j; const LAS float* sp = scr + (8 * c) * 33 + n;
        u32x2 o; o.x = pk4_fp8(sp[0 * 33] * scale, sp[1 * 33] * scale, sp[2 * 33] * scale, sp[3 * 33] * scale); o.y = pk4_fp8(sp[4 * 33] * scale, sp[5 * 33] * scale, sp[6 * 33] * scale, sp[7 * 33] * scale);
        *(u32x2*)(dst + (size_t)(drow0 + n) * dpitch + dk0 + k0 + 8 * c) = o; }
    LDS_WAIT(); asm volatile("" ::: "memory");
}
__device__ __forceinline__ void convert_small(Frame& F, int l, int gw, int NGW) {
    unsigned char* const ws_ = F.wsp(); float* const out_ = F.outp(); (void)ws_; (void)out_;
    LAS float* scr = (LAS float*)(F.lds + F.wave * 16384);
    bf16_t* wcat = (bf16_t*)(ws_ + WS_WSMALL + (size_t)l * WSMALL_LAYER); bf16_t* wmerge = wcat + (size_t)N1 * D; bf16_t* wo = wmerge + (size_t)D * ACTC;
    constexpr int I_IN = 16 * 128, I_GATE = 16 * 96, I_BR = 8 * 32, I_O = 16 * 32, NIT = I_IN + I_GATE + 3 * I_BR + I_O;
    for (int it = gw; it < NIT; it += NGW) {
        int r = it;
        if (r < I_IN) { transpose_item_fp8(F.in[I_WIN] + (size_t)l * D * INC, INC, 64 * (r / 128), 32 * (r % 128), (unsigned char*)wcat, D, 32 * (r % 128), 0, scr, F.lane, FP8_SW13); continue; } r -= I_IN;
        if (r < I_GATE) { transpose_item_fp8(F.in[I_WGATE] + (size_t)l * D * GC, GC, 64 * (r / 96), 32 * (r % 96), (unsigned char*)wcat + (size_t)ZC * D, D, 32 * (r % 96), 0, scr, F.lane, FP8_SW13); continue; } r -= I_GATE;
        if (r < 3 * I_BR) { const int br = r / I_BR; r %= I_BR; const float* src = F.in[I_WCONVOUT + br] + (size_t)l * 512 * D;
            transpose_item(src, D, 64 * (r / 32), 32 * (r % 32), wmerge, ACTC, 32 * (r % 32), 512 * br, scr, F.lane); continue; } r -= 3 * I_BR;
        transpose_item_fp8(F.in[I_WOUT] + (size_t)l * D * D, D, 64 * (r / 32), 32 * (r % 32), (unsigned char*)wo, D, 32 * (r % 32), 0, scr, F.lane, FP8_SW13);
    }
}
__device__ __forceinline__ void convert_moe(Frame& F, int l, int gw, int NGW) {
    unsigned char* const ws_ = F.wsp(); float* const out_ = F.outp(); (void)ws_; (void)out_;
    LAS float* scr = (LAS float*)(F.lds + F.wave * 16384);
    unsigned char* w13 = ws_ + WS_W13; unsigned char* w2t = ws_ + WS_W2;
    constexpr int I_UP = 16 * 64, I_DN = 32 * 32, PER_E = 2 * I_UP + I_DN, NIT = NE * PER_E;
    for (int it = gw; it < NIT; it += NGW) {
        const int e = it / PER_E; int r = it % PER_E;
        if (r < 2 * I_UP) { const int w3 = r / I_UP; r %= I_UP; const int n0 = 32 * (r % 64);
            const float* src = F.in[w3 ? I_W3 : I_W1] + ((size_t)l * NE + e) * D * FF;
            transpose_item_fp8(src, FF, 64 * (r / 64), n0, w13 + (size_t)e * 4096 * D, D, (n0 / 128) * 256 + (n0 % 128) + 128 * w3, 0, scr, F.lane, FP8_SW13); continue; } r -= 2 * I_UP;
        const float* src = F.in[I_W2] + ((size_t)l * NE + e) * FF * D;
        transpose_item_fp8(src, D, 64 * (r / 32), 32 * (r % 32), w2t + (size_t)e * D * FF, FF, 32 * (r % 32), 0, scr, F.lane, FP8_SW2);
    }
}
__device__ __forceinline__ void ada_item(Frame& F, int item) {
    unsigned char* const ws_ = F.wsp(); float* const out_ = F.outp(); (void)ws_; (void)out_;
    LAS float* sc = (LAS float*)F.lds;
    const int l = item / 96, cb = item % 96;
    { const float* cin = F.in[I_C]; for (int i = F.tid; i < 32 * 1024; i += 512) { const float c = cin[i]; sc[i] = c / (1.f + expf(-c)); } }
    __syncthreads();
    float acc[32];
#pragma unroll
    for (int b = 0; b < 32; ++b) acc[b] = 0.f;
    const float* W = F.in[I_WADA] + (size_t)l * D * 6144 + cb * 64 + F.lane;
    const int k0 = F.wave * 128;
    for (int k = k0; k < k0 + 128; k += 4) {
        float w[4];
#pragma unroll
        for (int q = 0; q < 4; ++q) w[q] = W[(size_t)(k + q) * 6144];
#pragma unroll
        for (int b = 0; b < 32; ++b) { const f32x4 s = *(const LAS f32x4*)(sc + b * 1024 + k); acc[b] += s[0] * w[0] + s[1] * w[1] + s[2] * w[2] + s[3] * w[3]; }
    }
    __syncthreads();
    LAS float* red = (LAS float*)F.lds;
#pragma unroll
    for (int b = 0; b < 32; ++b) red[(F.wave * 32 + b) * 64 + F.lane] = acc[b];
    __syncthreads();
    float* ada = (float*)(ws_ + WS_ADA) + (size_t)l * 32 * 6144; const float* bada = F.in[I_BADA];
    for (int o = F.tid; o < 2048; o += 512) { const int b = o >> 6, j = o & 63; float s = 0.f;
#pragma unroll
        for (int w = 0; w < 8; ++w) s += red[(w * 32 + b) * 64 + j];
        ada[(size_t)b * 6144 + cb * 64 + j] = s + bada[l * 6144 + cb * 64 + j]; }
    __syncthreads();
}

__device__ __forceinline__ void ra_math(f32x4 (&v)[4][4], const int rl0, const int row0, const int lane_, const float* ada_l, unsigned char* UF8, float* flog, const float* bfg_l, const LAS float* wff) {
    constexpr int RB = 4;
    const int b = row0 >> 11;
    const int ln_ = opaque_v(lane_);
    float sm[RB];
#pragma unroll
    for (int r = 0; r < RB; ++r) { sm[r] = 0.f;
#pragma unroll
        for (int j = 0; j < 4; ++j) sm[r] += (v[r][j].x + v[r][j].y) + (v[r][j].z + v[r][j].w); }
    wave_sum_n<RB>(sm);
    float sq[RB];
#pragma unroll
    for (int r = 0; r < RB; ++r) { const float mean = sm[r] * (1.f / D); sq[r] = 0.f;
#pragma unroll
        for (int j = 0; j < 4; ++j) { v[r][j] = v[r][j] - mean; sq[r] += (v[r][j].x * v[r][j].x + v[r][j].y * v[r][j].y) + (v[r][j].z * v[r][j].z + v[r][j].w * v[r][j].w); } }
    wave_sum_n<RB>(sq);
    float fl[RB * 8];
#pragma unroll
    for (int i = 0; i < RB * 8; ++i) fl[i] = 0.f;
    float rstd[RB];
#pragma unroll
    for (int r = 0; r < RB; ++r) rstd[r] = 1.f / sqrtf(sq[r] * (1.f / D) + LN_EPS);
#pragma unroll
    for (int j = 0; j < 4; ++j) { const f32x4 a = *((const f32x4*)(ada_l + (size_t)b * 6144) + ln_ + 64 * j), c = *((const f32x4*)(ada_l + (size_t)b * 6144 + D) + ln_ + 64 * j) + 1.f;
        f32x4 u[RB];
#pragma unroll
        for (int r = 0; r < RB; ++r) { u[r] = v[r][j] * rstd[r] * c + a;
            *((unsigned*)(UF8 + (size_t)(rl0 + r) * D) + ln_ + 64 * j) = pk4_fp8(u[r].x * FP8_SX, u[r].y * FP8_SX, u[r].z * FP8_SX, u[r].w * FP8_SX); }
#pragma unroll
        for (int h = 0; h < 8; ++h) { const f32x4 w = *(const LAS f32x4*)(wff + h * 1024 + 256 * j + 4 * ln_);
#pragma unroll
            for (int r = 0; r < RB; ++r) fl[r * 8 + h] += (u[r].x * w.x + u[r].y * w.y) + (u[r].z * w.z + u[r].w * w.w); } }
#pragma unroll
    for (int hf = 0; hf < 2; ++hf) { const float (&vv)[16] = *reinterpret_cast<const float (*)[16]>(&fl[hf * 16]);
        const int idx = (ln_ >> 2) & 15; const float xv = rs16(vv, ln_) + bfg_l[idx & 7];
        const float ls = fminf(xv, 0.f) - log1pf(expf(-fabsf(xv)));
        if ((ln_ & 3) == 0) flog[(size_t)(row0 + 2 * hf + (idx >> 3)) * 8 + (idx & 7)] = ls; }
}
__device__ __forceinline__ void stage_wff(Frame& F, int l) {
    LAS float* wff = (LAS float*)F.lds;
    const float* win = F.in[I_WIN] + (size_t)l * D * INC;
#pragma unroll 8
    for (int i = F.tid; i < 8192; i += 512) { const int k = i >> 3, h = i & 7; wff[h * 1024 + k] = win[(size_t)k * INC + ZC + h]; }
    __syncthreads();
}
__device__ __forceinline__ void phase_ra(Frame& F, int l, int hb, const bool stage) {
    unsigned char* const ws_ = F.wsp(); float* const out_ = F.outp();
    if (stage) stage_wff(F, l);
    const LAS float* wff = (const LAS float*)F.lds;
    const float* xsrc = (l == 0) ? F.in[I_X] : out_;
    const float* ada = (const float*)(ws_ + WS_ADA) + (size_t)l * 32 * 6144;
    unsigned char* UF8 = ws_ + (hb ? WS_UF8_H1 : WS_HOUT); float* flog = (float*)(ws_ + WS_FLOG); const float* bfg = F.in[I_BFORGET] + l * 8;
    const int gw = F.bid * NWAVES + F.wave, NGW = F.G * NWAVES;
    constexpr int RB = 4;
    for (int rl0 = gw * RB; rl0 < TH; rl0 += NGW * RB) {
        const int row0 = hb * TH + rl0;
        f32x4 v[RB][4];
#pragma unroll
        for (int r = 0; r < RB; ++r) { const f32x4* xr = (const f32x4*)(xsrc + (size_t)(row0 + r) * D) + F.lane;
#pragma unroll
            for (int j = 0; j < 4; ++j) v[r][j] = xr[64 * j]; }
        ra_math(v, rl0, row0, F.lane, ada, UF8, flog, bfg, wff);
    }
    __syncthreads();
}

constexpr int CV_HS = 0, CV_CO = 96256;
__device__ __forceinline__ void conv_unit(Frame& F, int l, int unit) {
    unsigned char* const ws_ = F.wsp();
    const int tid = opaque_v(F.tid), lane = tid & 63, wave = __builtin_amdgcn_readfirstlane(tid >> 6);
    const int bl = unit >> 5, t0 = (unit & 31) * 64;
    const bf16_t* Z = (const bf16_t*)(ws_ + WS_Z); bf16_t* ACT = (bf16_t*)(ws_ + WS_ACT);
    LAS unsigned char* L = F.lds;
#pragma unroll
    for (int hb2 = 0; hb2 < 2; ++hb2) {
        u32x4 av[6], gv[6];
#pragma unroll
        for (int q = 0; q < 6; ++q) { const int item = tid + 512 * (6 * hb2 + q), i = item >> 6, cg = item & 63, t = t0 - 30 + i;
            av[q] = (u32x4){0u, 0u, 0u, 0u}; gv[q] = (u32x4){0u, 0u, 0u, 0u};
            if (item < 94 * 64 && t >= 0) { const bf16_t* zr = Z + (size_t)(bl * SEQ + t) * ZP + cg * 8; av[q] = *(const u32x4*)(zr + C_AVAL); gv[q] = *(const u32x4*)(zr + C_AGATE); } }
#pragma unroll
        for (int q = 0; q < 6; ++q) { const int item = tid + 512 * (6 * hb2 + q), i = item >> 6, cg = item & 63;
            if (item < 94 * 64) { u32x4 o;
#pragma unroll
                for (int k = 0; k < 4; ++k) o[k] = pk2(bflo(av[q][k]) * sigm(bflo(gv[q][k])), bfhi(av[q][k]) * sigm(bfhi(gv[q][k])));
                *(LAS u32x4*)(L + CV_HS + (i * 512 + cg * 8) * 2) = o; } }
    }
    const float* convw = F.in[I_CONVW] + (size_t)l * 31 * 512; const float* clng = F.in[I_CLNG] + l * 512; const float* clnb = F.in[I_CLNB] + l * 512;
    float w[31];
#pragma unroll
    for (int j = 0; j < 31; ++j) w[j] = convw[j * 512 + tid];
    const float cb = F.in[I_CONVB][l * 512 + tid];
    const int ti = wave * 2 + (lane >> 5), seg = lane & 31;
    f32x4 lg[4], lb[4];
#pragma unroll
    for (int i = 0; i < 4; ++i) { lg[i] = *(const f32x4*)(clng + i * 128 + seg * 4); lb[i] = *(const f32x4*)(clnb + i * 128 + seg * 4); }
    __syncthreads();
    for (int sb = 0; sb < 4; ++sb) {
        float hr[46];
#pragma unroll
        for (int i = 0; i < 46; ++i) hr[i] = __uint_as_float((unsigned)(*(const LAS bf16_t*)(L + CV_HS + ((sb * 16 + i) * 512 + tid) * 2)) << 16);
#pragma unroll
        for (int i = 0; i < 16; ++i) { float o = cb;
#pragma unroll
            for (int j = 0; j < 31; ++j) o += w[j] * hr[i + j];
            *(LAS float*)(L + CV_CO + (i * 512 + tid) * 4) = o; }
        __syncthreads();
        { f32x4 v[4]; float s = 0.f;
#pragma unroll
          for (int i = 0; i < 4; ++i) { v[i] = *(const LAS f32x4*)(L + CV_CO + (ti * 512 + i * 128 + seg * 4) * 4); s += (v[i].x + v[i].y) + (v[i].z + v[i].w); }
          s += swz_xor1(s); s += swz_xor2(s); s += swz_xor4(s); s += swz_xor8(s); s += swz_xor16(s);
          const float mean = s * (1.f / 512.f); float s2 = 0.f;
#pragma unroll
          for (int i = 0; i < 4; ++i) { v[i] = v[i] - mean; s2 += (v[i].x * v[i].x + v[i].y * v[i].y) + (v[i].z * v[i].z + v[i].w * v[i].w); }
          s2 += swz_xor1(s2); s2 += swz_xor2(s2); s2 += swz_xor4(s2); s2 += swz_xor8(s2); s2 += swz_xor16(s2);
          const float rstd = 1.f / sqrtf(s2 * (1.f / 512.f) + LN_EPS);
          bf16_t* orow = ACT + (size_t)(bl * SEQ + t0 + sb * 16 + ti) * ACTC;
#pragma unroll
          for (int i = 0; i < 4; ++i) { const f32x4 y = v[i] * rstd * lg[i] + lb[i];
              *(u32x2*)(orow + i * 128 + seg * 4) = (u32x2){pk2(y.x * sigm(y.x), y.y * sigm(y.y)), pk2(y.z * sigm(y.z), y.w * sigm(y.w))}; } }
        __syncthreads();
    }
}

constexpr int RP = 72;
constexpr int R_QS = 0, R_QD = 9216, R_KS = 18432, R_VT = 27648, R_PS = 46080, R_OS = 55296, R_OSP = 132;
constexpr int RA_KT = 0, RA_VT = 9216;
__device__ __forceinline__ bf16x8 ldfrag(const LAS unsigned char* base, int row, int col) { return *(const LAS bf16x8*)(base + (row * RP + col) * 2); }
__device__ __forceinline__ float ret_lg2(int h) { return log1pf(-exp2f(-5.f - (float)h)) * 1.4426950408889634f; }
struct RaIn { u32x2 k1, k2; f32x4 cs, sn; u32x4 va, vb; };
__device__ __forceinline__ void ret_a_load(Frame& F, int item, int tid, RaIn& in) {
    unsigned char* const ws_ = F.wsp();
    const int n = item & 31, h = (item >> 5) & 3, bl = item >> 7;
    const bf16_t* Z = (const bf16_t*)(ws_ + WS_Z); const float* rotc = (const float*)(ws_ + WS_ROT); const float* rots = rotc + 2048 * 32;
    const int srow = tid >> 3, j4 = tid & 7, t = n * 64 + srow; const bf16_t* zr = Z + (size_t)(bl * SEQ + t) * ZP;
    in.k1 = *(const u32x2*)(zr + C_RK + h * 64 + 4 * j4); in.k2 = *(const u32x2*)(zr + C_RK + h * 64 + 32 + 4 * j4);
    in.cs = *(const f32x4*)(rotc + t * 32 + 4 * j4); in.sn = *(const f32x4*)(rots + t * 32 + 4 * j4);
    in.va = *(const u32x4*)(zr + C_RV + h * 128 + j4 * 16); in.vb = *(const u32x4*)(zr + C_RV + h * 128 + j4 * 16 + 8);
}
__device__ __forceinline__ void ret_a_compute(Frame& F, int item, int tid, const RaIn& in) {
    unsigned char* const ws_ = F.wsp();
    const int h = (item >> 5) & 3;
    const int lane = tid & 63, w = __builtin_amdgcn_readfirstlane(tid >> 6), fr = lane & 15, fq = lane >> 4;
    LAS unsigned char* L = F.lds;
    bf16_t* KV = (bf16_t*)(ws_ + WS_HOUT) + (size_t)item * 8192;
    const float lg2 = ret_lg2(h);
    const int srow = tid >> 3, j4 = tid & 7;
    { const u32x2 k1 = in.k1, k2 = in.k2; const f32x4 cs = in.cs, sn = in.sn; const u32x4 va = in.va, vb = in.vb;
      const float dk = 0.125f * __builtin_amdgcn_exp2f(lg2 * (float)(63 - srow));
      const float y1[4] = {bflo(k1.x), bfhi(k1.x), bflo(k1.y), bfhi(k1.y)}, y2[4] = {bflo(k2.x), bfhi(k2.x), bflo(k2.y), bfhi(k2.y)};
#pragma unroll
      for (int i = 0; i < 4; ++i) { const float ka = y1[i] * cs[i] - y2[i] * sn[i], kb = y1[i] * sn[i] + y2[i] * cs[i];
        *(LAS bf16_t*)(L + RA_KT + ((4 * j4 + i) * RP + srow) * 2) = (bf16_t)f2bf(ka * dk); *(LAS bf16_t*)(L + RA_KT + ((32 + 4 * j4 + i) * RP + srow) * 2) = (bf16_t)f2bf(kb * dk); }
#pragma unroll
      for (int i = 0; i < 4; ++i) { const unsigned a = va[i], b = vb[i];
        *(LAS bf16_t*)(L + RA_VT + ((j4 * 16 + 2 * i) * RP + srow) * 2) = (bf16_t)(a & 0xffffu); *(LAS bf16_t*)(L + RA_VT + ((j4 * 16 + 2 * i + 1) * RP + srow) * 2) = (bf16_t)(a >> 16);
        *(LAS bf16_t*)(L + RA_VT + ((j4 * 16 + 8 + 2 * i) * RP + srow) * 2) = (bf16_t)(b & 0xffffu); *(LAS bf16_t*)(L + RA_VT + ((j4 * 16 + 8 + 2 * i + 1) * RP + srow) * 2) = (bf16_t)(b >> 16); } }
    LDS_BARRIER();
    { const int dt = w & 3, et0 = (w >> 2) * 4;
      const bf16x8 kt0 = ldfrag(L + RA_KT, dt * 16 + fr, fq * 8), kt1 = ldfrag(L + RA_KT, dt * 16 + fr, 32 + fq * 8);
#pragma unroll
      for (int q = 0; q < 4; ++q) { const int et = et0 + q;
        const bf16x8 v0 = ldfrag(L + RA_VT, et * 16 + fr, fq * 8), v1 = ldfrag(L + RA_VT, et * 16 + fr, 32 + fq * 8);
        f32x4 sacc = (f32x4){0.f, 0.f, 0.f, 0.f};
        sacc = __builtin_amdgcn_mfma_f32_16x16x32_bf16(kt0, v0, sacc, 0, 0, 0); sacc = __builtin_amdgcn_mfma_f32_16x16x32_bf16(kt1, v1, sacc, 0, 0, 0);
        *(u32x2*)(KV + (et * 16 + fr) * 64 + dt * 16 + 4 * fq) = (u32x2){pk2(sacc[0], sacc[1]), pk2(sacc[2], sacc[3])}; } }
    LDS_BARRIER();
}
__device__ __forceinline__ void ret_a_run(Frame& F, int nitems) {
    const int tid = opaque_v(F.tid);
    RaIn cur, nxt; int it = F.bid;
    if (it < nitems) ret_a_load(F, it, tid, cur);
    for (; it < nitems; it += F.G) {
        const int itn = it + F.G;
        if (itn < nitems) ret_a_load(F, itn, tid, nxt);
        ret_a_compute(F, it, tid, cur);
        cur = nxt;
    }
}
__device__ __forceinline__ void ret_scan_item(Frame& F, int c) {
    unsigned char* const ws_ = F.wsp();
    const int bh = c >> 2, idx = (c & 3) * 512 + F.tid;
    const float cdec = __builtin_amdgcn_exp2f(ret_lg2(bh & 3) * 64.f);
    const f32x4* KV = (const f32x4*)(ws_ + WS_HOUT) + (size_t)bh * 32 * 2048 + idx; u32x2* Sg = (u32x2*)(ws_ + WS_U) + (size_t)bh * 32 * 2048 + idx;
    float z0 = 0.f; asm volatile("" : "+v"(z0));
    f32x4 st = (f32x4){z0, z0, z0, z0};
#pragma unroll
    for (int hf = 0; hf < 2; ++hf) {
        f32x4 kv[16];
#pragma unroll
        for (int n = 0; n < 16; ++n) kv[n] = KV[(size_t)(hf * 16 + n) * 2048];
#pragma unroll
        for (int n = 0; n < 16; ++n) { Sg[(size_t)(hf * 16 + n) * 2048] = (u32x2){pk2(st[0], st[1]), pk2(st[2], st[3])}; st = st * cdec + kv[n]; }
    }
}
struct RcIn { u32x2 q1, q2, k1, k2; f32x4 cs, sn; u32x4 va, vb, ga, gb; u32x2 kv[4]; };
constexpr int R_STL = 89088;
__device__ __forceinline__ void ret_c_load(Frame& F, int item, int tid, RcIn& in) {
    unsigned char* const ws_ = F.wsp();
    const int n = item & 31, h = (item >> 5) & 3, bl = item >> 7;
    const int lane = tid & 63, w = __builtin_amdgcn_readfirstlane(tid >> 6), fr = lane & 15, fq = lane >> 4;
    const bf16_t* Z = (const bf16_t*)(ws_ + WS_Z); const float* rotc = (const float*)(ws_ + WS_ROT); const float* rots = rotc + 2048 * 32;
    { const u32x2* KVg = (const u32x2*)(ws_ + WS_HOUT) + (size_t)item * 2048 + tid;
#pragma unroll
      for (int q = 0; q < 4; ++q) in.kv[q] = KVg[512 * q]; }
    (void)fr; (void)fq;
    const int srow = tid >> 3, j4 = tid & 7, t = n * 64 + srow; const bf16_t* zr = Z + (size_t)(bl * SEQ + t) * ZP;
    in.q1 = *(const u32x2*)(zr + C_RQ + h * 64 + 4 * j4); in.q2 = *(const u32x2*)(zr + C_RQ + h * 64 + 32 + 4 * j4);
    in.k1 = *(const u32x2*)(zr + C_RK + h * 64 + 4 * j4); in.k2 = *(const u32x2*)(zr + C_RK + h * 64 + 32 + 4 * j4);
    in.cs = *(const f32x4*)(rotc + t * 32 + 4 * j4); in.sn = *(const f32x4*)(rots + t * 32 + 4 * j4);
    in.va = *(const u32x4*)(zr + C_RV + h * 128 + j4 * 16); in.vb = *(const u32x4*)(zr + C_RV + h * 128 + j4 * 16 + 8);
    { const int j = w * 8 + (lane >> 3), cs16 = (lane & 7) * 16; const size_t grow = (size_t)(bl * SEQ + n * 64 + j);
      in.ga = *(const u32x4*)(Z + grow * ZP + C_RG + h * 128 + cs16); in.gb = *(const u32x4*)(Z + grow * ZP + C_RG + h * 128 + cs16 + 8); }
}
__device__ __forceinline__ void ret_c_compute(Frame& F, int item, int tid, const RcIn& in, f32x4 (&st)[4]) {
    unsigned char* const ws_ = F.wsp();
    const int n = item & 31, h = (item >> 5) & 3, bl = item >> 7;
    const int lane = tid & 63, w = __builtin_amdgcn_readfirstlane(tid >> 6), fr = lane & 15, fq = lane >> 4;
    LAS unsigned char* L = F.lds;
    bf16_t* ACT = (bf16_t*)(ws_ + WS_ACT);
    const float lg2 = ret_lg2(h);
    const int srow = tid >> 3, j4 = tid & 7;
    const int jt = w & 3, et0 = (w >> 2) * 4;
    { const u32x2 q1 = in.q1, q2 = in.q2, k1 = in.k1, k2 = in.k2; const f32x4 cs = in.cs, sn = in.sn; const u32x4 va = in.va, vb = in.vb;
      const float dq = __builtin_amdgcn_exp2f(lg2 * (float)(srow + 1));
      float qa[4], qb[4], ka[4], kb[4];
      { const float x1[4] = {bflo(q1.x), bfhi(q1.x), bflo(q1.y), bfhi(q1.y)}, x2[4] = {bflo(q2.x), bfhi(q2.x), bflo(q2.y), bfhi(q2.y)};
        const float y1[4] = {bflo(k1.x), bfhi(k1.x), bflo(k1.y), bfhi(k1.y)}, y2[4] = {bflo(k2.x), bfhi(k2.x), bflo(k2.y), bfhi(k2.y)};
#pragma unroll
        for (int i = 0; i < 4; ++i) { qa[i] = x1[i] * cs[i] - x2[i] * sn[i]; qb[i] = x1[i] * sn[i] + x2[i] * cs[i]; ka[i] = (y1[i] * cs[i] - y2[i] * sn[i]) * 0.125f; kb[i] = (y1[i] * sn[i] + y2[i] * cs[i]) * 0.125f; } }
      *(LAS u32x2*)(L + R_QS + (srow * RP + 4 * j4) * 2) = (u32x2){pk2(qa[0], qa[1]), pk2(qa[2], qa[3])};
      *(LAS u32x2*)(L + R_QS + (srow * RP + 32 + 4 * j4) * 2) = (u32x2){pk2(qb[0], qb[1]), pk2(qb[2], qb[3])};
      *(LAS u32x2*)(L + R_QD + (srow * RP + 4 * j4) * 2) = (u32x2){pk2(qa[0] * dq, qa[1] * dq), pk2(qa[2] * dq, qa[3] * dq)};
      *(LAS u32x2*)(L + R_QD + (srow * RP + 32 + 4 * j4) * 2) = (u32x2){pk2(qb[0] * dq, qb[1] * dq), pk2(qb[2] * dq, qb[3] * dq)};
      *(LAS u32x2*)(L + R_KS + (srow * RP + 4 * j4) * 2) = (u32x2){pk2(ka[0], ka[1]), pk2(ka[2], ka[3])};
      *(LAS u32x2*)(L + R_KS + (srow * RP + 32 + 4 * j4) * 2) = (u32x2){pk2(kb[0], kb[1]), pk2(kb[2], kb[3])};
#pragma unroll
      for (int i = 0; i < 4; ++i) { const unsigned a = va[i], b = vb[i];
        *(LAS bf16_t*)(L + R_VT + ((j4 * 16 + 2 * i) * RP + srow) * 2) = (bf16_t)(a & 0xffffu); *(LAS bf16_t*)(L + R_VT + ((j4 * 16 + 2 * i + 1) * RP + srow) * 2) = (bf16_t)(a >> 16);
        *(LAS bf16_t*)(L + R_VT + ((j4 * 16 + 8 + 2 * i) * RP + srow) * 2) = (bf16_t)(b & 0xffffu); *(LAS bf16_t*)(L + R_VT + ((j4 * 16 + 8 + 2 * i + 1) * RP + srow) * 2) = (bf16_t)(b >> 16); } }
#pragma unroll
    for (int q = 0; q < 4; ++q) { const int idx = tid + 512 * q, e = idx >> 4, d4 = idx & 15;
        *(LAS u32x2*)(L + R_STL + (e * RP + 4 * d4) * 2) = (u32x2){pk2(st[q].x, st[q].y), pk2(st[q].z, st[q].w)}; }
    LDS_BARRIER();
#pragma unroll
    for (int tt = 0; tt < 2; ++tt) { const int tl = 2 * w + tt, ti = tl >> 2, tj = tl & 3; f32x4 a = (f32x4){0.f, 0.f, 0.f, 0.f};
#pragma unroll
        for (int ks = 0; ks < 2; ++ks) a = __builtin_amdgcn_mfma_f32_16x16x32_bf16(ldfrag(L + R_KS, tj * 16 + fr, ks * 32 + fq * 8), ldfrag(L + R_QS, ti * 16 + fr, ks * 32 + fq * 8), a, 0, 0, 0);
        const int jj = ti * 16 + fr, l0 = tj * 16 + 4 * fq; float p[4];
#pragma unroll
        for (int i = 0; i < 4; ++i) { const int dlt = jj - (l0 + i); p[i] = a[i] * __builtin_amdgcn_exp2f(lg2 * (float)(dlt < 0 ? -dlt : dlt)); }
        *(LAS u32x2*)(L + R_PS + (jj * RP + l0) * 2) = (u32x2){pk2(p[0], p[1]), pk2(p[2], p[3])}; }
    LDS_BARRIER();
    { const bf16x8 pf0 = ldfrag(L + R_PS, jt * 16 + fr, fq * 8), pf1 = ldfrag(L + R_PS, jt * 16 + fr, 32 + fq * 8);
      const bf16x8 qd0 = ldfrag(L + R_QD, jt * 16 + fr, fq * 8), qd1 = ldfrag(L + R_QD, jt * 16 + fr, 32 + fq * 8);
#pragma unroll
      for (int q = 0; q < 4; ++q) { const int et = et0 + q;
        const bf16x8 v0 = ldfrag(L + R_VT, et * 16 + fr, fq * 8), v1 = ldfrag(L + R_VT, et * 16 + fr, 32 + fq * 8);
        f32x4 a = (f32x4){0.f, 0.f, 0.f, 0.f};
        a = __builtin_amdgcn_mfma_f32_16x16x32_bf16(v0, pf0, a, 0, 0, 0); a = __builtin_amdgcn_mfma_f32_16x16x32_bf16(v1, pf1, a, 0, 0, 0);
        a = __builtin_amdgcn_mfma_f32_16x16x32_bf16(ldfrag(L + R_STL, et * 16 + fr, fq * 8), qd0, a, 0, 0, 0); a = __builtin_amdgcn_mfma_f32_16x16x32_bf16(ldfrag(L + R_STL, et * 16 + fr, 32 + fq * 8), qd1, a, 0, 0, 0);
        *(LAS f32x4*)(L + R_OS + ((jt * 16 + fr) * R_OSP + et * 16 + 4 * fq) * 4) = a; } }
    LDS_BARRIER();
    { const int j = w * 8 + (lane >> 3), cs16 = (lane & 7) * 16;
      f32x4 o[4]; float s = 0.f;
#pragma unroll
      for (int i = 0; i < 4; ++i) { o[i] = *(const LAS f32x4*)(L + R_OS + (j * R_OSP + cs16 + 4 * i) * 4); s += (o[i].x + o[i].y) + (o[i].z + o[i].w); }
      s += swz_xor1(s); s += swz_xor2(s); s += swz_xor4(s);
      const float mean = s * (1.f / 128.f); float s2 = 0.f;
#pragma unroll
      for (int i = 0; i < 4; ++i) { o[i] = o[i] - mean; s2 += (o[i].x * o[i].x + o[i].y * o[i].y) + (o[i].z * o[i].z + o[i].w * o[i].w); }
      s2 += swz_xor1(s2); s2 += swz_xor2(s2); s2 += swz_xor4(s2);
      const float rstd = 1.f / sqrtf(s2 * (1.f / 128.f) + LN_EPS);
      const size_t grow = (size_t)(bl * SEQ + n * 64 + j);
      const u32x4 ga = in.ga, gb = in.gb;
      u32x4 oa, ob;
#pragma unroll
      for (int i = 0; i < 4; ++i) { const unsigned g = (i < 2) ? ga[2 * i] : gb[2 * (i - 2)], g2 = (i < 2) ? ga[2 * i + 1] : gb[2 * (i - 2) + 1];
        const float g0 = bflo(g), g1 = bfhi(g), g2a = bflo(g2), g3 = bfhi(g2);
        const unsigned p0 = pk2(g0 * sigm(g0) * o[i].x * rstd, g1 * sigm(g1) * o[i].y * rstd), p1 = pk2(g2a * sigm(g2a) * o[i].z * rstd, g3 * sigm(g3) * o[i].w * rstd);
        if (i < 2) { oa[2 * i] = p0; oa[2 * i + 1] = p1; } else { ob[2 * (i - 2)] = p0; ob[2 * (i - 2) + 1] = p1; } }
      *(u32x4*)(ACT + grow * ACTC + 512 + h * 128 + cs16) = oa; *(u32x4*)(ACT + grow * ACTC + 512 + h * 128 + cs16 + 8) = ob; }
    LDS_BARRIER();
    { const float cdec = __builtin_amdgcn_exp2f(lg2 * 64.f);
#pragma unroll
      for (int q = 0; q < 4; ++q) st[q] = st[q] * cdec + bf4_to_f32(in.kv[q]); }
}
__device__ __forceinline__ void ret_c_run(Frame& F) {
    unsigned char* const ws_ = F.wsp();
    const int tid = opaque_v(F.tid);
    const int bh = F.bid >> 2, n0 = (F.bid & 3) * 8;
    const float cdec = __builtin_amdgcn_exp2f(ret_lg2(bh & 3) * 64.f);
    f32x4 st[4];
#pragma unroll
    for (int q = 0; q < 4; ++q) st[q] = (f32x4){0.f, 0.f, 0.f, 0.f};
    { const u32x2* KVg = (const u32x2*)(ws_ + WS_HOUT) + (size_t)(bh * 32) * 2048 + tid;
      for (int m0 = 0; m0 < n0; m0 += 4) { u32x2 kv[4][4];
#pragma unroll
          for (int m = 0; m < 4; ++m)
#pragma unroll
              for (int q = 0; q < 4; ++q) kv[m][q] = KVg[(size_t)(m0 + m) * 2048 + 512 * q];
#pragma unroll
          for (int m = 0; m < 4; ++m)
#pragma unroll
              for (int q = 0; q < 4; ++q) st[q] = st[q] * cdec + bf4_to_f32(kv[m][q]); } }
    RcIn cur, nxt; const int it0 = bh * 32 + n0;
    ret_c_load(F, it0, tid, cur);
    for (int j = 0; j < 8; ++j) {
        if (j + 1 < 8) ret_c_load(F, it0 + j + 1, tid, nxt);
        ret_c_compute(F, it0 + j, tid, cur, st);
        cur = nxt;
    }
}

namespace attn_body {
using bf16=__hip_bfloat16;
using bf16x8=__attribute__((ext_vector_type(8)))short;
using s16x4=__attribute__((ext_vector_type(4)))short;
using f32x16=__attribute__((ext_vector_type(16)))float;
using u32x4=__attribute__((ext_vector_type(4)))unsigned;
constexpr int SEQ=2048,D=64,DM=4160,OPITCH=1536;
constexpr int NW=8,QBLK=32,QB=QBLK*NW,KVBLK=64,NQB=SEQ/QB;
__device__ __forceinline__ int crow(int r,int hi){return (r&3)+8*(r>>2)+4*hi;}
#define SBAR() __builtin_amdgcn_sched_barrier(0)
__device__ __forceinline__ void cmask(f32x16&p0,f32x16&p1,int jb,int qrel,int hi){
  const float NEG=-INFINITY; int kb=64*jb+4*hi;
  #pragma unroll
  for(int r=0;r<16;++r){int kv=kb+(r&3)+8*(r>>2); if(kv>qrel)p0[r]=NEG; if(kv+32>qrel)p1[r]=NEG;}
}

constexpr int NSLOT=3, SLOTB=8192;
constexpr int LDS_K=0, LDS_V=NSLOT*SLOTB, LDS_WS=2*NSLOT*SLOTB, LDS_OST=LDS_WS+NW*64*4, LDS_CUM=LDS_OST+NW*4096, LDS_BYTES=LDS_CUM+SEQ*4;
constexpr float C2=0.125f*1.4426950408889634f;
__device__ __forceinline__ void glds16(const void*gsrc,unsigned lds_dst){unsigned keep;
  asm volatile("s_mov_b32 %0, m0\n\ts_mov_b32 m0, %2\n\ts_nop 0\n\tglobal_load_lds_dwordx4 %1, off\n\ts_mov_b32 m0, %0":"=&s"(keep):"v"(gsrc),"s"(lds_dst):"memory");}
__device__ __forceinline__ float max3f(float a,float b,float c){float r;asm("v_max3_f32 %0, %1, %2, %3":"=v"(r):"v"(a),"v"(b),"v"(c));return r;}
__device__ __forceinline__ float max2f(float a,float b){float r;asm("v_max_f32_e32 %0, %1, %2":"=v"(r):"v"(a),"v"(b));return r;}
__device__ __forceinline__ float fadd_s(float a,float b){float r;asm("v_add_f32_e32 %0, %1, %2":"=v"(r):"v"(a),"v"(b));return r;}
__device__ __forceinline__ float fsub_s(float a,float b){float r;asm("v_sub_f32_e32 %0, %1, %2":"=v"(r):"v"(a),"v"(b));return r;}
typedef float f32x2_t __attribute__((ext_vector_type(2))); typedef __bf16 bf16x2_t __attribute__((ext_vector_type(2)));
__device__ __forceinline__ unsigned cvtpk_s(float lo,float hi){f32x2_t v={lo,hi};bf16x2_t b=__builtin_convertvector(v,bf16x2_t);return __builtin_bit_cast(unsigned,b);}
#define WAIT_BAR(N) asm volatile("s_waitcnt vmcnt(" #N ") lgkmcnt(0)\n\ts_barrier":::"memory")

__device__ __forceinline__ void qkt(f32x16&p0,f32x16&p1,const char*Kslot,const bf16x8*qr,int r32,int hi){
  const char*kb=Kslot+hi*1024+r32*16;
  #pragma unroll
  for(int d0=0;d0<4;++d0){
    const bf16x8 b0=*reinterpret_cast<const bf16x8*>(kb+d0*2048);
    const bf16x8 b1=*reinterpret_cast<const bf16x8*>(kb+d0*2048+512);
    if(d0==0){p0=__builtin_amdgcn_mfma_f32_32x32x16_bf16(b0,qr[0],p0,0,0,0);p1=__builtin_amdgcn_mfma_f32_32x32x16_bf16(b1,qr[0],p1,0,0,0);}
    else{p0=__builtin_amdgcn_mfma_f32_32x32x16_bf16(b0,qr[d0],p0,0,0,0);p1=__builtin_amdgcn_mfma_f32_32x32x16_bf16(b1,qr[d0],p1,0,0,0);}}
}
typedef __attribute__((address_space(3))) const char* lds_cptr;
typedef short v4i16_t __attribute__((ext_vector_type(4)));
__device__ __forceinline__ void kload8(bf16x8*kf,lds_cptr kp){
  kf[0]=*(const __attribute__((address_space(3))) bf16x8*)(kp);      kf[1]=*(const __attribute__((address_space(3))) bf16x8*)(kp+512);
  kf[2]=*(const __attribute__((address_space(3))) bf16x8*)(kp+2048); kf[3]=*(const __attribute__((address_space(3))) bf16x8*)(kp+2560);
  kf[4]=*(const __attribute__((address_space(3))) bf16x8*)(kp+4096); kf[5]=*(const __attribute__((address_space(3))) bf16x8*)(kp+4608);
  kf[6]=*(const __attribute__((address_space(3))) bf16x8*)(kp+6144); kf[7]=*(const __attribute__((address_space(3))) bf16x8*)(kp+6656);
}
__device__ __forceinline__ void kload2(bf16x8*kf,lds_cptr kp,int j){ kf[2*j]=*(const __attribute__((address_space(3))) bf16x8*)(kp+j*2048); kf[2*j+1]=*(const __attribute__((address_space(3))) bf16x8*)(kp+j*2048+512); }
__device__ __forceinline__ s16x4 vtr(lds_cptr p){ return __builtin_bit_cast(s16x4,__builtin_amdgcn_ds_read_tr16_b64_v4i16((__attribute__((address_space(3))) v4i16_t*)p)); }
__device__ __forceinline__ float rowmax(const f32x16&p0,const f32x16&p1){
  float a=max3f(p0[0],p0[1],p1[0]),b=max3f(p0[2],p0[3],p1[1]);a=max3f(a,p1[2],p1[3]);
  #pragma unroll
  for(int r=4;r<16;r+=4){a=max3f(a,p0[r],p0[r+1]);b=max3f(b,p0[r+2],p0[r+3]);a=max3f(a,p1[r],p1[r+1]);b=max3f(b,p1[r+2],p1[r+3]);}
  const float m=max2f(a,b);
  auto rr=__builtin_amdgcn_permlane32_swap(__float_as_uint(m),__float_as_uint(m),false,false);
  return max2f(__uint_as_float(rr[0]),__uint_as_float(rr[1]));
}
__device__ __forceinline__ void pv(f32x16*o,int vb,bf16x8 pa0,bf16x8 pa1,bf16x8 pa2,bf16x8 pa3){
  #pragma unroll
  for(int d0=0;d0<2;++d0){s16x4 lo[4],hi[4];
    #pragma unroll
    for(int ks=0;ks<4;++ks){
      asm volatile("ds_read_b64_tr_b16 %0,%1 offset:%c2":"=&v"(lo[ks]):"v"(vb),"i"(d0*4096+ks*1024):"memory");
      asm volatile("ds_read_b64_tr_b16 %0,%1 offset:%c2":"=&v"(hi[ks]):"v"(vb),"i"(d0*4096+ks*1024+512):"memory");}
    asm volatile("s_waitcnt lgkmcnt(0)":::"memory");SBAR();
    #define PK(k) (bf16x8){lo[k][0],lo[k][1],lo[k][2],lo[k][3],hi[k][0],hi[k][1],hi[k][2],hi[k][3]}
    o[d0]=__builtin_amdgcn_mfma_f32_32x32x16_bf16(pa0,PK(0),o[d0],0,0,0);
    o[d0]=__builtin_amdgcn_mfma_f32_32x32x16_bf16(pa1,PK(1),o[d0],0,0,0);
    o[d0]=__builtin_amdgcn_mfma_f32_32x32x16_bf16(pa2,PK(2),o[d0],0,0,0);
    o[d0]=__builtin_amdgcn_mfma_f32_32x32x16_bf16(pa3,PK(3),o[d0],0,0,0);
    #undef PK
  }
}

#ifndef ATTN_STORE16
#define ATTN_STORE16(p,v) (*(u32x4*)(p)=(v))
#endif
template<int THRL> __device__ __forceinline__ void attn_unit(int b,int h,int qb,const bf16*Q,const bf16*__restrict__ K,const bf16*__restrict__ V,bf16*O,const float*__restrict__ cumg,char*shm,const int tid_){
  const int tid=opaque_v(tid_),lane=tid&63,r32=lane&31,hi=lane>>5; const int wid=__builtin_amdgcn_readfirstlane(tid>>6);
  const long rowbase=(long)b*SEQ; const int q0=qb*QB;
  const bf16*Qw=Q+(rowbase+q0+wid*QBLK)*DM+h*D;
  const bf16*Kh=K+rowbase*DM+h*D,*Vh=V+rowbase*DM+h*D;
  const unsigned lds0=(unsigned)(uintptr_t)shm;
  float*wsf=(float*)(shm+LDS_WS)+wid*64;
  const bf16*ksrc=Kh+(long)lane*DM+wid*8;
  const bf16*vsrc=Vh+(long)(16*(wid&3)+(lane>>2))*DM+(wid>>2)*32+(lane&3)*8;
  const unsigned kdst=lds0+LDS_K+wid*1024, vdst=lds0+LDS_V+wid*1024;
  #define DMA_K(t,slot) glds16(ksrc+(long)(t)*KVBLK*DM,(unsigned)__builtin_amdgcn_readfirstlane(kdst+(slot)))
  #define DMA_V(t,slot) glds16(vsrc+(long)(t)*KVBLK*DM,(unsigned)__builtin_amdgcn_readfirstlane(vdst+(slot)))
  const int vb0=(int)(lds0+LDS_V)+((lane>>4)&1)*32+(lane&3)*8+(4*hi+((lane&15)>>2))*64;
  const char*Kbase=shm+LDS_K; bf16x8 kf[8];
  const lds_cptr shm3=(lds_cptr)shm; const lds_cptr kp0=shm3+LDS_K+hi*1024+r32*16; const lds_cptr vp0=shm3+LDS_V+((lane>>4)&1)*32+(lane&3)*8+(4*hi+((lane&15)>>2))*64;
  const int NT=(q0+QB)/KVBLK;
  typedef float f32x4_t __attribute__((ext_vector_type(4)));
  f32x4_t cumv=f32x4_t{0.f,0.f,0.f,0.f}; if(4*tid<q0+QB)cumv=*reinterpret_cast<const f32x4_t*>(cumg+4*tid);
  float cqm=cumg[q0+wid*QBLK+r32];
  DMA_K(0,0);DMA_V(0,0);DMA_K(1,SLOTB);
  bf16x8 qr[4];
  #pragma unroll
  for(int d0=0;d0<4;++d0)qr[d0]=*reinterpret_cast<const bf16x8*>(&Qw[(long)r32*DM+d0*16+hi*8]);
  float mhat=0.f,l_reg=0.f;f32x16 o[2];o[0]=f32x16{};o[1]=f32x16{};
  const lds_cptr cum3=(lds_cptr)shm+LDS_CUM+hi*16;
  #define CINIT1(C,t,half) do{ const lds_cptr cp_=cum3+(t)*256+(half)*128; \
    _Pragma("unroll") for(int g_=0;g_<4;++g_){ const f32x4_t a_=*(const __attribute__((address_space(3))) f32x4_t*)(cp_+g_*32); \
      _Pragma("unroll") for(int i_=0;i_<4;++i_){ C[4*g_+i_]=cqm-a_[i_]; } } }while(0)
  #define CINIT(C0,C1,t) do{ CINIT1(C0,t,0); CINIT1(C1,t,1); }while(0)
  #define NLD(P,t,half,g) do{ const f32x4_t a_=*(const __attribute__((address_space(3))) f32x4_t*)(cum3+((t)+1)*256+(half)*128+(g)*32); P[4*(g)]=a_[0];P[4*(g)+1]=a_[1];P[4*(g)+2]=a_[2];P[4*(g)+3]=a_[3]; }while(0)
  #define NSB(P,g) do{ P[4*(g)]=cqm-P[4*(g)];P[4*(g)+1]=cqm-P[4*(g)+1];P[4*(g)+2]=cqm-P[4*(g)+2];P[4*(g)+3]=cqm-P[4*(g)+3]; }while(0)
  const int qrel=wid*QBLK+r32;
  #define CMASK(P0,P1,t) do{int jb_=(t)-(NT-4); if(jb_>=0)cmask(P0,P1,jb_,qrel,hi);}while(0)
  bool resc=false;
  #define START(P0,P1) do{ const float rm=rowmax(P0,P1); resc=false; \
    { const float dl=rm; mhat=fadd_s(mhat,dl); \
      _Pragma("unroll") for(int r=0;r<16;++r){P0[r]=fsub_s(P0[r],dl);P1[r]=fsub_s(P1[r],dl);} \
      cqm=fsub_s(cqm,dl); } \
    _Pragma("unroll") for(int r=0;r<16;++r)P0[r]=__builtin_amdgcn_exp2f(P0[r]); }while(0)
  #define RESC() do{ if(resc){ asm volatile("s_waitcnt lgkmcnt(0)":::"memory"); \
      _Pragma("unroll") for(int d_=0;d_<2;++d_) _Pragma("unroll") for(int r=0;r<16;++r)o[d_][r]*=wsf[crow(r,hi)]; } }while(0)
  f32x16 pA0,pA1,pB0,pB1;
  int sl_prev=0,sl_cur=0,sl_next=SLOTB;
  #define ROT() do{sl_prev=sl_cur;sl_cur=sl_next;sl_next=(sl_next==(NSLOT-1)*SLOTB)?0:sl_next+SLOTB;}while(0)
  DMA_K(2,2*SLOTB);
  *reinterpret_cast<f32x4_t*>(shm+LDS_CUM+16*tid)=cumv;
  WAIT_BAR(3);
  CINIT(pA0,pA1,0); qkt(pA0,pA1,Kbase,qr,r32,hi);asm volatile("s_nop 15\n\ts_nop 7":"+v"(pA0),"+v"(pA1));CMASK(pA0,pA1,0);
  START(pA0,pA1);
  CINIT(pB0,pB1,1);
  _Pragma("unroll") for(int r=0;r<16;++r)pA1[r]=__builtin_amdgcn_exp2f(pA1[r]);
  WAIT_BAR(0);
  DMA_K(3,0);DMA_V(1,SLOTB);
  ROT();
  kload8(kf,kp0+sl_cur);
  WAIT_BAR(2);
  s16x4 vlo[8],vhi[8]; u32x4 pw0,pw1,pw2,pw3;
  #define PKW(P,B) cvtpk_s(P[B],P[B+1])
  #define PAF(k) __builtin_bit_cast(bf16x8,pw##k)
  #define VFR(i) (bf16x8){vlo[i][0],vlo[i][1],vlo[i][2],vlo[i][3],vhi[i][0],vhi[i][1],vhi[i][2],vhi[i][3]}
  #define PIN(x) asm volatile("":"+v"(x))
  #define MX3(a,b,c) __builtin_fmaxf(__builtin_fmaxf((a),(b)),(c))
  #define GAPA(MF,A0,A1,A2,A3,W0,W1,PW) do{ MF; sacc+=A0; sacc+=A1; sacc+=A2; sacc+=A3; PIN(sacc); W0; W1; PIN(PW); SBAR(); }while(0)
  #define EX(v) __builtin_amdgcn_exp2f(v)
  #define GAPB(MF,X,B,E) do{ MF; X[B]=EX(X[B]); X[B+1]=EX(X[B+1]); X[B+2]=EX(X[B+2]); X[B+3]=EX(X[B+3]); E; PIN(X); SBAR(); }while(0)
  #define VRD(i) do{ vlo[i]=vtr(vp_+(((i)>>2)*4096+((i)&3)*1024)); vhi[i]=vtr(vp_+(((i)>>2)*4096+((i)&3)*1024+512)); }while(0)
  #define KRD(G,j) do{ if(G){ kload2(kf,kp0+sl_next,j); SBAR(); } }while(0)
  #define STEP(C0,C1,P0,P1,t,GK,GV,GL) do{ SBAR(); \
    const lds_cptr vp_=vp0+sl_prev; \
    VRD(0); SBAR(); float sacc=(P0[0]+P0[1]); \
    GAPA(C0=__builtin_amdgcn_mfma_f32_32x32x16_bf16(kf[0],qr[0],C0,0,0,0), P0[2],P0[3],P0[4],P0[5],     pw0[0]=PKW(P0,0), pw0[1]=PKW(P0,2), pw0); \
    VRD(4); SBAR(); GAPA(C1=__builtin_amdgcn_mfma_f32_32x32x16_bf16(kf[1],qr[0],C1,0,0,0), P0[6],P0[7],P0[8],P0[9],     pw0[2]=PKW(P0,4), pw0[3]=PKW(P0,6), pw0); \
    VRD(1); SBAR(); GAPA(C0=__builtin_amdgcn_mfma_f32_32x32x16_bf16(kf[2],qr[1],C0,0,0,0),   P0[10],P0[11],P0[12],P0[13], pw1[0]=PKW(P0,8), pw1[1]=PKW(P0,10), pw1); \
    VRD(5); SBAR(); GAPA(C1=__builtin_amdgcn_mfma_f32_32x32x16_bf16(kf[3],qr[1],C1,0,0,0),   P0[14],P0[15],P1[0],P1[1],   pw1[2]=PKW(P0,12),pw1[3]=PKW(P0,14), pw1); \
    VRD(2); SBAR(); GAPA(C0=__builtin_amdgcn_mfma_f32_32x32x16_bf16(kf[4],qr[2],C0,0,0,0),   P1[2],P1[3],P1[4],P1[5],     pw2[0]=PKW(P1,0), pw2[1]=PKW(P1,2), pw2); \
    VRD(6); SBAR(); GAPA(C1=__builtin_amdgcn_mfma_f32_32x32x16_bf16(kf[5],qr[2],C1,0,0,0),   P1[6],P1[7],P1[8],P1[9],     pw2[2]=PKW(P1,4), pw2[3]=PKW(P1,6), pw2); \
    VRD(3); SBAR(); GAPA(C0=__builtin_amdgcn_mfma_f32_32x32x16_bf16(kf[6],qr[3],C0,0,0,0),   P1[10],P1[11],P1[12],P1[13], pw3[0]=PKW(P1,8), pw3[1]=PKW(P1,10), pw3); \
    VRD(7); SBAR(); GAPA(C1=__builtin_amdgcn_mfma_f32_32x32x16_bf16(kf[7],qr[3],C1,0,0,0),   P1[14],P1[15],0.f,0.f,       pw3[2]=PKW(P1,12),pw3[3]=PKW(P1,14), pw3); \
    l_reg+=sacc; \
    if(GK){DMA_K((t)+3,sl_cur);} if(GV){DMA_V((t)+1,sl_next);} \
    CMASK(C0,C1,t); \
    { float a=MX3(C0[0],C0[1],C1[0]),b=MX3(C0[2],C0[3],C1[1]); a=MX3(a,C1[2],C1[3]); \
      _Pragma("unroll") for(int r=4;r<16;r+=4){a=MX3(a,C0[r],C0[r+1]);b=MX3(b,C0[r+2],C0[r+3]);a=MX3(a,C1[r],C1[r+1]);b=MX3(b,C1[r+2],C1[r+3]);} \
      float rm=__builtin_fmaxf(a,b); { auto rr=__builtin_amdgcn_permlane32_swap(__float_as_uint(rm),__float_as_uint(rm),false,false); rm=__builtin_fmaxf(__uint_as_float(rr[0]),__uint_as_float(rr[1])); } \
      resc=false; \
      if(__builtin_expect(__any(rm>(float)THRL),0)){ const float dl=__builtin_fmaxf(rm,0.f); mhat+=dl; \
        _Pragma("unroll") for(int r=0;r<16;++r){C0[r]-=dl;C1[r]-=dl;} \
        cqm-=dl; \
        const float f=__builtin_amdgcn_exp2f(-dl); l_reg*=f; if(hi==0)wsf[r32]=f; resc=true; } } \
    SBAR(); \
    GAPB(o[0]=__builtin_amdgcn_mfma_f32_32x32x16_bf16(PAF(0),VFR(0),o[0],0,0,0), C0,0, NLD(P0,t,0,0)); \
    GAPB(o[1]=__builtin_amdgcn_mfma_f32_32x32x16_bf16(PAF(0),VFR(4),o[1],0,0,0), C0,4, NLD(P0,t,0,1); NSB(P0,0)); \
    KRD(GL,0); GAPB(o[0]=__builtin_amdgcn_mfma_f32_32x32x16_bf16(PAF(1),VFR(1),o[0],0,0,0), C0,8, NLD(P0,t,0,2); NSB(P0,1)); \
    KRD(GL,1); GAPB(o[1]=__builtin_amdgcn_mfma_f32_32x32x16_bf16(PAF(1),VFR(5),o[1],0,0,0), C0,12, NLD(P0,t,0,3); NSB(P0,2)); \
    KRD(GL,2); GAPB(o[0]=__builtin_amdgcn_mfma_f32_32x32x16_bf16(PAF(2),VFR(2),o[0],0,0,0), C1,0, NLD(P1,t,1,0); NSB(P0,3)); \
    KRD(GL,3); GAPB(o[1]=__builtin_amdgcn_mfma_f32_32x32x16_bf16(PAF(2),VFR(6),o[1],0,0,0), C1,4, NLD(P1,t,1,1); NSB(P1,0)); \
    GAPB(o[0]=__builtin_amdgcn_mfma_f32_32x32x16_bf16(PAF(3),VFR(3),o[0],0,0,0), C1,8, NLD(P1,t,1,2); NSB(P1,1)); \
    GAPB(o[1]=__builtin_amdgcn_mfma_f32_32x32x16_bf16(PAF(3),VFR(7),o[1],0,0,0), C1,12, NLD(P1,t,1,3); NSB(P1,2)); NSB(P1,3); SBAR(); \
    }while(0)
  int t=1;
  #undef CMASK
  #define CMASK(P0,P1,t) do{}while(0)
  for(;t+5<NT;t+=2){
    STEP(pB0,pB1,pA0,pA1,t,true,true,true);     WAIT_BAR(2); RESC(); ROT();
    STEP(pA0,pA1,pB0,pB1,t+1,true,true,true);   WAIT_BAR(2); RESC(); ROT();
  }
  #undef CMASK
  #define CMASK(P0,P1,t) do{int jb_=(t)-(NT-4); if(jb_>=0)cmask(P0,P1,jb_,qrel,hi);}while(0)
  #define ENDW(tt) do{ if((tt)+3<NT){WAIT_BAR(2);} else if((tt)+2<NT){WAIT_BAR(1);} else {WAIT_BAR(0);} }while(0)
  for(;t+1<NT;t+=2){
    STEP(pB0,pB1,pA0,pA1,t,(t+3<NT),(t+1<NT),(t+1<NT));       ENDW(t);   RESC(); ROT();
    STEP(pA0,pA1,pB0,pB1,t+1,(t+4<NT),(t+2<NT),(t+2<NT));     ENDW(t+1); RESC(); ROT();
  }
  STEP(pB0,pB1,pA0,pA1,NT-1,false,false,false); RESC();
  { float sacc=pB0[0]+pB0[1]; _Pragma("unroll") for(int r=2;r<16;++r)sacc+=pB0[r]; _Pragma("unroll") for(int r=0;r<16;++r)sacc+=pB1[r]; l_reg+=sacc;
    pw0=(u32x4){PKW(pB0,0),PKW(pB0,2),PKW(pB0,4),PKW(pB0,6)};pw1=(u32x4){PKW(pB0,8),PKW(pB0,10),PKW(pB0,12),PKW(pB0,14)};pw2=(u32x4){PKW(pB1,0),PKW(pB1,2),PKW(pB1,4),PKW(pB1,6)};pw3=(u32x4){PKW(pB1,8),PKW(pB1,10),PKW(pB1,12),PKW(pB1,14)};
    SBAR(); pv(o,vb0+sl_cur,PAF(0),PAF(1),PAF(2),PAF(3)); }
  #undef PKW
  #undef PAF
  #undef VFR
  #undef PIN
  #undef MX3
  #undef GAPA
  #undef GAPB
  #undef EX
  #undef VRD
  #undef KRD
  #undef STEP
  #undef ENDW
  {auto rr=__builtin_amdgcn_permlane32_swap(__float_as_uint(l_reg),__float_as_uint(l_reg),false,false);l_reg=__uint_as_float(rr[0])+__uint_as_float(rr[1]);}
  if(hi==0)wsf[32+r32]=l_reg;asm volatile("s_waitcnt lgkmcnt(0)":::"memory");
  float rli[16];
  #pragma unroll
  for(int r=0;r<16;++r)rli[r]=__builtin_amdgcn_rcpf(wsf[32+crow(r,hi)]);
  bf16*Ow=O+(rowbase+q0+wid*QBLK)*OPITCH+h*D;
  { bf16*stg=(bf16*)(shm+LDS_OST)+wid*2048;
    #pragma unroll
    for(int r=0;r<16;++r){const int orow=crow(r,hi);
      #pragma unroll
      for(int d0=0;d0<2;++d0)stg[orow*64+d0*32+r32]=__float2bfloat16(o[d0][r]*rli[r]);}
    asm volatile("s_waitcnt lgkmcnt(0)":::"memory");
    #pragma unroll
    for(int i=0;i<4;++i){const int row=i*8+(lane>>3),ch=lane&7; const u32x4 v=*(const u32x4*)(stg+row*64+ch*8); ATTN_STORE16(Ow+(long)row*OPITCH+ch*8,v);} }
  asm volatile("s_waitcnt lgkmcnt(0)\n\ts_barrier":::"memory");
  #undef DMA_K
  #undef DMA_V
  #undef CMASK
  #undef START
  #undef RESC
  #undef ROT
  #undef CINIT
  #undef CINIT1
  #undef NLD
  #undef NSB
}
constexpr int ATTN_LDS_BYTES=LDS_BYTES;
#undef SBAR
#undef WAIT_BAR
}

constexpr size_t WS_CUM = 10 * MiB;
__device__ __forceinline__ void cum_item(Frame& F, int hb, int c) {
    unsigned char* const ws_ = F.wsp();
    const int tid = F.tid, lane = F.lane, w = F.wave;
    const float* flog = (const float*)(ws_ + WS_FLOG) + ((size_t)(hb * BH + (c >> 3)) * SEQ) * 8 + (c & 7);
    float* cumg = (float*)(ws_ + WS_CUM) + (size_t)c * SEQ;
    LAS float* red = (LAS float*)F.lds;
    float v[4]; float s = 0.f;
#pragma unroll
    for (int i = 0; i < 4; ++i) { v[i] = flog[(size_t)(4 * tid + i) * 8] * 1.4426950408889634f; s += v[i]; v[i] = s; }
    float inc = s;
#pragma unroll
    for (int o = 1; o < 64; o <<= 1) { const float y = __int_as_float(__builtin_amdgcn_ds_bpermute(((lane - o) & 63) << 2, __float_as_int(inc))); if (lane >= o) inc += y; }
    if (lane == 63) red[w] = inc;
    __syncthreads();
    float base = inc - s;
    for (int ww = 0; ww < w; ++ww) base += red[ww];
    *(f32x4*)(cumg + 4 * tid) = (f32x4){base + v[0], base + v[1], base + v[2], base + v[3]};
    __syncthreads();
}

__device__ __forceinline__ void phase_rf(Frame& F, int l, int hb, const bool xb  ) {
    unsigned char* const ws_ = F.wsp(); float* const out_ = F.outp();
    LAS float* wrt = (LAS float*)F.lds;
    LAS int* hist = (LAS int*)(F.lds + HIST_OFF);
    { const float* wr_ = F.in[I_WROUTER];
#pragma unroll 8
      for (int i = F.tid; i < 16384; i += 512) { const int k = i >> 4, e = i & 15; wrt[e * 1024 + k] = wr_[i]; } }
    if (F.tid < 16) hist[F.tid] = 0;
    __syncthreads();
    const float* xsrc = F.in[I_X];
    const float* ada = (const float*)(ws_ + WS_ADA) + (size_t)l * 32 * 6144;
    const bf16_t* HO = (const bf16_t*)(ws_ + WS_HOUT); unsigned char* U2 = ws_ + WS_U2;
    int* ridx = (int*)(ws_ + WS_RIDX); float* rw = (float*)(ws_ + WS_RW);
    const float* lg = F.in[I_LN1G] + l * D; const float* lb = F.in[I_LN1B] + l * D; const float* brt = F.in[I_BROUTER];
    constexpr int RB = 4;
    for (int it = 0; it < SEGROWS / NWAVES / RB; ++it) {
        const int rl0 = F.bid * SEGROWS + F.wave * (SEGROWS / NWAVES) + it * RB, row0 = hb * TH + rl0, b = row0 >> 11;
        const float* ab = ada + (size_t)b * 6144;
        f32x4 v[RB][4]; float sm[RB];
#pragma unroll
        for (int r = 0; r < RB; ++r) sm[r] = 0.f;
#pragma unroll
        for (int j = 0; j < 4; ++j) { const f32x4 g1 = *((const f32x4*)(ab + 2 * D) + F.lane + 64 * j);
#pragma unroll
            for (int r = 0; r < RB; ++r) { f32x4 x; if (xb) x = bf4_to_f32(*((const u32x2*)((const unsigned char*)out_ + (size_t)(row0 + r) * 4096) + F.lane + 64 * j)); else x = *((const f32x4*)(xsrc + (size_t)(row0 + r) * D) + F.lane + 64 * j);
                const unsigned long long hw = *((const unsigned long long*)(HO + (size_t)(rl0 + r) * D) + F.lane + 64 * j);
                const unsigned h0 = (unsigned)hw, h1 = (unsigned)(hw >> 32);
                v[r][j] = (f32x4){DN_ALPHA * x.x + g1.x * bflo(h0), DN_ALPHA * x.y + g1.y * bfhi(h0), DN_ALPHA * x.z + g1.z * bflo(h1), DN_ALPHA * x.w + g1.w * bfhi(h1)};
                sm[r] += (v[r][j].x + v[r][j].y) + (v[r][j].z + v[r][j].w); } }
        wave_sum_n<RB>(sm);
        float sq[RB];
#pragma unroll
        for (int r = 0; r < RB; ++r) { const float mean = sm[r] * (1.f / D); sq[r] = 0.f;
#pragma unroll
            for (int j = 0; j < 4; ++j) { v[r][j] = v[r][j] - mean; sq[r] += (v[r][j].x * v[r][j].x + v[r][j].y * v[r][j].y) + (v[r][j].z * v[r][j].z + v[r][j].w * v[r][j].w); } }
        wave_sum_n<RB>(sq);
#pragma unroll
        for (int r = 0; r < RB; ++r) { const float rstd = 1.f / sqrtf(sq[r] * (1.f / D) + LN_EPS); sm[r] = 0.f;
#pragma unroll
            for (int j = 0; j < 4; ++j) { const f32x4 g = *((const f32x4*)lg + F.lane + 64 * j), bb = *((const f32x4*)lb + F.lane + 64 * j); v[r][j] = v[r][j] * rstd * g + bb;
                *((u32x2*)((unsigned char*)out_ + (size_t)(row0 + r) * 4096 + 2048) + F.lane + 64 * j) = (u32x2){pk2(v[r][j].x, v[r][j].y), pk2(v[r][j].z, v[r][j].w)};
                sm[r] += (v[r][j].x + v[r][j].y) + (v[r][j].z + v[r][j].w); } }
        wave_sum_n<RB>(sm);
#pragma unroll
        for (int r = 0; r < RB; ++r) { const float mean = sm[r] * (1.f / D); sq[r] = 0.f;
#pragma unroll
            for (int j = 0; j < 4; ++j) { v[r][j] = v[r][j] - mean; sq[r] += (v[r][j].x * v[r][j].x + v[r][j].y * v[r][j].y) + (v[r][j].z * v[r][j].z + v[r][j].w * v[r][j].w); } }
        wave_sum_n<RB>(sq);
        float rstd2[RB];
#pragma unroll
        for (int r = 0; r < RB; ++r) rstd2[r] = 1.f / sqrtf(sq[r] * (1.f / D) + LN_EPS);
        float lgt[RB * 16];
#pragma unroll
        for (int i = 0; i < RB * 16; ++i) lgt[i] = 0.f;
#pragma unroll
        for (int j = 0; j < 4; ++j) { const f32x4 sh = *((const f32x4*)(ab + 3 * D) + F.lane + 64 * j), sc = *((const f32x4*)(ab + 4 * D) + F.lane + 64 * j) + 1.f;
            f32x4 u[RB];
#pragma unroll
            for (int r = 0; r < RB; ++r) { u[r] = v[r][j] * rstd2[r] * sc + sh;
                *((unsigned*)(U2 + (size_t)(row0 + r) * D) + F.lane + 64 * j) = pk4_fp8(u[r].x * FP8_SX, u[r].y * FP8_SX, u[r].z * FP8_SX, u[r].w * FP8_SX); }
#pragma unroll
            for (int e = 0; e < 16; ++e) { const f32x4 wv = *(const LAS f32x4*)(wrt + e * 1024 + 256 * j + 4 * F.lane);
#pragma unroll
                for (int r = 0; r < RB; ++r) lgt[r * 16 + e] += (u[r].x * wv.x + u[r].y * wv.y) + (u[r].z * wv.z + u[r].w * wv.w); } }
        float sgl[RB], sell[RB];
        { const float brl = brt[(F.lane >> 2) & 15];
#pragma unroll
          for (int r = 0; r < RB; ++r) { const float (&vv)[16] = *reinterpret_cast<const float (*)[16]>(&lgt[r * 16]); const float z = rs16(vv, F.lane); sgl[r] = 1.f / (1.f + expf(-z)); sell[r] = sgl[r] + brl; } }
#pragma unroll
        for (int r = 0; r < RB; ++r) {
            float sg[16], sel[16];
#pragma unroll
            for (int e = 0; e < 16; ++e) { sg[e] = lane_bcast(sgl[r], 4 * e); sel[e] = lane_bcast(sell[r], 4 * e); }
            int bg = 0; float bgs = -INFINITY;
#pragma unroll
            for (int g = 0; g < 4; ++g) { float m1 = -INFINITY, m2 = -INFINITY;
#pragma unroll
                for (int q = 0; q < 4; ++q) { const float x = sel[4 * g + q]; if (x > m1) { m2 = m1; m1 = x; } else if (x > m2) m2 = x; }
                const float gs = m1 + m2; if (gs > bgs) { bgs = gs; bg = g; } }
            int i1 = 0, i2 = 0; float m1 = -INFINITY, m2 = -INFINITY, s1 = 0.f, s2v = 0.f;
#pragma unroll
            for (int g = 0; g < 4; ++g) if (g == bg) {
#pragma unroll
                for (int q = 0; q < 4; ++q) { const float x = sel[4 * g + q], sv = sg[4 * g + q];
                    if (x > m1) { m2 = m1; i2 = i1; s2v = s1; m1 = x; i1 = 4 * g + q; s1 = sv; } else if (x > m2) { m2 = x; i2 = 4 * g + q; s2v = sv; } } }
            if (F.lane == 0) { const float inv = 1.f / (s1 + s2v); const int row = row0 + r;
                ridx[(size_t)row * 2] = i1; ridx[(size_t)row * 2 + 1] = i2; rw[(size_t)row * 2] = s1 * inv; rw[(size_t)row * 2 + 1] = s2v * inv;
                atomicAdd((int*)&hist[i1], 1); atomicAdd((int*)&hist[i2], 1); }
        }
    }
    __syncthreads();
    if (F.tid < 16) ((int*)(ws_ + WS_SEGCNT))[(hb * 256 + F.bid) * 16 + F.tid] = hist[F.tid];
    __syncthreads();
}

__device__ __forceinline__ int wave_sum_i(int v) {
    v += __builtin_amdgcn_ds_swizzle(v, SWZ_XOR(1)); v += __builtin_amdgcn_ds_swizzle(v, SWZ_XOR(2)); v += __builtin_amdgcn_ds_swizzle(v, SWZ_XOR(4));
    v += __builtin_amdgcn_ds_swizzle(v, SWZ_XOR(8)); v += __builtin_amdgcn_ds_swizzle(v, SWZ_XOR(16));
    auto rr = __builtin_amdgcn_permlane32_swap((unsigned)v, (unsigned)v, false, false); return (int)(rr[0] + rr[1]);
}
__device__ __forceinline__ void moe_tables(Frame& F, int seg_a, int seg_b, LAS int* base_ab  ) {
    unsigned char* const ws_ = F.wsp();
    LAS int* sc = (LAS int*)F.lds;
    LAS int* pexp = (LAS int*)(F.lds + PEXP_OFF);
    LAS int* tmp = (LAS int*)(F.lds + 32768);
    const int* segcnt = (const int*)(ws_ + WS_SEGCNT);
#pragma unroll 8
    for (int i = F.tid; i < NSEG * 16; i += 512) sc[i] = segcnt[i];
    __syncthreads();
#pragma unroll
    for (int ee = 0; ee < 2; ++ee) { const int e = 2 * F.wave + ee; int tot = 0, pa = 0, pb = 0;
#pragma unroll
        for (int q = 0; q < 8; ++q) { const int sgm = F.lane + 64 * q; const int c = sc[sgm * 16 + e]; tot += c; pa += (sgm < seg_a) ? c : 0; pb += (sgm < seg_b) ? c : 0; }
        tot = wave_sum_i(tot); pa = wave_sum_i(pa); pb = wave_sum_i(pb);
        if (F.lane == 0) { tmp[e] = tot; tmp[16 + e] = pa; tmp[32 + e] = pb; } }
    __syncthreads();
    if (F.tid == 0) { int p = 0;
#pragma unroll
        for (int e = 0; e < 16; ++e) { tmp[48 + e] = p * 256; tmp[64 + e] = p; p += (tmp[e] + 255) >> 8; }
        pexp[NPMAX] = p; }
    __syncthreads();
    for (int t = F.tid; t < NPMAX; t += 512) { int e = 0;
#pragma unroll
        for (int q = 1; q < 16; ++q) e += (t >= tmp[64 + q]) ? 1 : 0;
        pexp[t] = e; }
    if (base_ab && F.tid < 32) base_ab[F.tid] = tmp[48 + (F.tid & 15)] + tmp[16 + F.tid];
    __syncthreads();
}

__device__ __forceinline__ void phase_rg(Frame& F) {
    unsigned char* const ws_ = F.wsp(); float* const out_ = F.outp(); (void)ws_; (void)out_;
    LAS int* base_ab = (LAS int*)(F.lds + 36864);
    LAS int* epos = (LAS int*)(F.lds + 40960);
    moe_tables(F, F.bid, 256 + F.bid, base_ab);
    const int* ridx = (const int*)(ws_ + WS_RIDX); int* rpos = (int*)(ws_ + WS_RPOS);
    if (F.wave < 2) { const int seg = F.wave * 256 + F.bid; int run[16];
#pragma unroll
        for (int e = 0; e < 16; ++e) run[e] = base_ab[F.wave * 16 + e];
        for (int ch = 0; ch < 4; ++ch) { const int ent = ch * 64 + F.lane; const int row = seg * SEGROWS + (ent >> 1); const int me = ridx[(size_t)row * 2 + (ent & 1)]; int pos = 0;
#pragma unroll
            for (int e = 0; e < 16; ++e) { const unsigned long long mask = __ballot(me == e); if (me == e) pos = run[e] + __popcll(mask & ((1ull << F.lane) - 1ull)); run[e] += __popcll(mask); }
            epos[F.wave * 256 + ent] = pos; rpos[(size_t)row * 2 + (ent & 1)] = pos; } }
    __syncthreads();
    const unsigned char* U2 = ws_ + WS_U2; unsigned char* XS = ws_ + WS_XS;
    for (int i0 = F.wave * 64; i0 < F.wave * 64 + 64; i0 += 16) {
        u32x4 a[8]; int pos[16];
#pragma unroll
        for (int q = 0; q < 8; ++q) { const int i = i0 + 2 * q, sg = i >> 8, ent = i & 255; const int row = (sg * 256 + F.bid) * SEGROWS + (ent >> 1); pos[2 * q] = epos[i]; pos[2 * q + 1] = epos[i + 1];
            a[q] = *((const u32x4*)(U2 + (size_t)row * D) + F.lane); }
#pragma unroll
        for (int q = 0; q < 8; ++q) { *((u32x4*)(XS + (size_t)pos[2 * q] * D) + F.lane) = a[q]; *((u32x4*)(XS + (size_t)pos[2 * q + 1] * D) + F.lane) = a[q]; } }
    __syncthreads();
}

__device__ __forceinline__ void phase_rj(Frame& F, int l, const bool fuse_next  ) {
    unsigned char* const ws_ = F.wsp(); float* const out_ = F.outp();
    if (fuse_next) stage_wff(F, l + 1);
    const LAS float* wff = (const LAS float*)F.lds;
    const float* ada_n = (const float*)(ws_ + WS_ADA) + (size_t)(l + 1) * 32 * 6144; unsigned char* UF8 = ws_ + WS_HOUT; float* flog = (float*)(ws_ + WS_FLOG); const float* bfg_n = F.in[I_BFORGET] + (l + 1) * 8;
    const float* ada = (const float*)(ws_ + WS_ADA) + (size_t)l * 32 * 6144;
    const unsigned char* Y = ws_ + WS_XS;   const int* rpos = (const int*)(ws_ + WS_RPOS); const float* rw = (const float*)(ws_ + WS_RW);
    const float* lg = F.in[I_LN2G] + l * D; const float* lb = F.in[I_LN2B] + l * D;
    const int gw = F.bid * NWAVES + F.wave, NGW = F.G * NWAVES;
    constexpr int RB = 4;
    for (int row0 = gw * RB; row0 < T; row0 += NGW * RB) { const int b = row0 >> 11;
        int p0[RB], p1[RB]; float w0[RB], w1[RB];
#pragma unroll
        for (int r = 0; r < RB; ++r) { p0[r] = rpos[(size_t)(row0 + r) * 2]; p1[r] = rpos[(size_t)(row0 + r) * 2 + 1]; w0[r] = rw[(size_t)(row0 + r) * 2] * (1.f / FP8_SY); w1[r] = rw[(size_t)(row0 + r) * 2 + 1] * (1.f / FP8_SY); }
        f32x4 v[RB][4]; float sm[RB];
#pragma unroll
        for (int r = 0; r < RB; ++r) sm[r] = 0.f;
#pragma unroll
        for (int j = 0; j < 4; ++j) { const f32x4 g2 = *((const f32x4*)(ada + (size_t)b * 6144 + 5 * D) + F.lane + 64 * j);
#pragma unroll
            for (int r = 0; r < RB; ++r) { const f32x4 x = bf4_to_f32(*((const u32x2*)((const unsigned char*)out_ + (size_t)(row0 + r) * 4096 + 2048) + F.lane + 64 * j));
                const int a = *((const int*)(Y + (size_t)p0[r] * D) + F.lane + 64 * j), c = *((const int*)(Y + (size_t)p1[r] * D) + F.lane + 64 * j);
                const f32x2 alo = __builtin_amdgcn_cvt_pk_f32_fp8(a, false), ahi = __builtin_amdgcn_cvt_pk_f32_fp8(a, true), clo = __builtin_amdgcn_cvt_pk_f32_fp8(c, false), chi = __builtin_amdgcn_cvt_pk_f32_fp8(c, true);
                v[r][j] = (f32x4){DN_ALPHA * x.x + g2.x * (w0[r] * alo.x + w1[r] * clo.x), DN_ALPHA * x.y + g2.y * (w0[r] * alo.y + w1[r] * clo.y),
                                  DN_ALPHA * x.z + g2.z * (w0[r] * ahi.x + w1[r] * chi.x), DN_ALPHA * x.w + g2.w * (w0[r] * ahi.y + w1[r] * chi.y)};
                sm[r] += (v[r][j].x + v[r][j].y) + (v[r][j].z + v[r][j].w); } }
        wave_sum_n<RB>(sm);
        float sq[RB];
#pragma unroll
        for (int r = 0; r < RB; ++r) { const float mean = sm[r] * (1.f / D); sq[r] = 0.f;
#pragma unroll
            for (int j = 0; j < 4; ++j) { v[r][j] = v[r][j] - mean; sq[r] += (v[r][j].x * v[r][j].x + v[r][j].y * v[r][j].y) + (v[r][j].z * v[r][j].z + v[r][j].w * v[r][j].w); } }
        wave_sum_n<RB>(sq);
#pragma unroll
        for (int r = 0; r < RB; ++r) { const float rstd = 1.f / sqrtf(sq[r] * (1.f / D) + LN_EPS);
#pragma unroll
            for (int j = 0; j < 4; ++j) { const f32x4 g = *((const f32x4*)lg + F.lane + 64 * j), bb = *((const f32x4*)lb + F.lane + 64 * j);
                v[r][j] = v[r][j] * rstd * g + bb;
                if (fuse_next) *((u32x2*)((unsigned char*)out_ + (size_t)(row0 + r) * 4096) + F.lane + 64 * j) = (u32x2){pk2(v[r][j].x, v[r][j].y), pk2(v[r][j].z, v[r][j].w)};
                else *((f32x4*)(out_ + (size_t)(row0 + r) * D) + F.lane + 64 * j) = v[r][j]; } }
        if (fuse_next) { const bool h1 = row0 >= TH; ra_math(v, h1 ? row0 - TH : row0, row0, F.lane, ada_n, h1 ? ws_ + WS_UF8_H1 : UF8, flog, bfg_n, wff); }
    }
}

#ifndef PHASE_MASK
#define PHASE_MASK 0xFFFF
#endif
#define PH_ON (ph >= lo && ph < hi)
#define SITE(k) (PH_ON && ((PHASE_MASK >> (k)) & 1))
#define LOCALF Frame F = F0; F.wave = opaque_s(F0.wave); F.lane = opaque_v((int)__builtin_amdgcn_mbcnt_hi(~0u, __builtin_amdgcn_mbcnt_lo(~0u, 0u))); F.tid = F.wave * 64 + F.lane; F.bid = opaque_s(F0.bid); F.G = opaque_s(F0.G)
#define PH_END do { if (MK_ONE_LAUNCH && ph >= lo && ph + 1 < hi) xcd_barrier(bar, F0.wave == 0 && __builtin_amdgcn_mbcnt_hi(~0u, __builtin_amdgcn_mbcnt_lo(~0u, 0u)) == 0u); ++ph; } while (0)

template <int l_, int hb_> __device__ __forceinline__ void half_phases(const Frame& F0, const XcdBarrier& bar, int& ph, const int lo, const int hi) {

            if constexpr (l_ == 0 && hb_ == 0) {
            if (SITE(1)) { LOCALF; const int l = opaque_s(l_); for (int hb = 0; hb < opaque_s(NHALF); ++hb) phase_ra(F, l, hb, hb == 0); }
            PH_END;
            }
            if (SITE(2)) { LOCALF; const int l = opaque_s(l_), hb = opaque_s(hb_); (void)l; (void)hb;
                if (F.bid < 128) cum_item(F, hb, F.bid);
                unsigned char* const ws = F.wsp(); const bf16_t* wcat = (const bf16_t*)(ws + WS_WSMALL + (size_t)l * WSMALL_LAYER);
                pg8::EpiZG E{(bf16_t*)(ws + WS_Z), (bf16_t*)(ws + WS_G), F.in[I_BGATE] + l * GC, 0, 1.f / (FP8_SX * FP8_SW13)};
                { pg8::Gemm g{(const bf16_t*)(ws + (hb ? WS_UF8_H1 : WS_HOUT)), wcat, D / 2, 0}; pg8::StaticOrder S; S.init(TH, N1, F.G, F.bid);
                  pg8::gemm_phase<pg8::EpiZG, pg8::StaticOrder, true>(F.lds, F.tid, g, S, E); }
            }
            PH_END;
            if (SITE(3)) { LOCALF; const int l = opaque_s(l_), hb = opaque_s(hb_); (void)l; (void)hb;
                ret_a_run(F, BH * 4 * 32);
                const int bhl = F.bid >> 1, odd = F.bid & 1;
                for (int i = 0; i < 4; ++i) { const int qb = odd ? (i == 0 ? 6 : i == 1 ? 5 : i == 2 ? 2 : 1) : (i == 0 ? 7 : i == 1 ? 4 : i == 2 ? 3 : 0);
                    unsigned char* const ws = F.wsp(); const attn_body::bf16* Zb = (const attn_body::bf16*)(ws + WS_Z);
                    attn_body::attn_unit<8>(bhl >> 3, bhl & 7, qb, Zb + C_FQ, Zb + C_FK, Zb + C_FV, (attn_body::bf16*)(ws + WS_ACT) + 1024, (const float*)(ws + WS_CUM) + (size_t)bhl * SEQ, (char*)F.lds, F.tid); }
                for (int it = F.bid; it < 512; it += F.G) { __syncthreads(); conv_unit(F, l, it); }
            }
            PH_END;
            if (SITE(12)) { LOCALF; const int l = opaque_s(l_), hb = opaque_s(hb_); (void)l; (void)hb;
                ret_c_run(F);
            }
            PH_END;
            if (SITE(4)) { LOCALF; const int l = opaque_s(l_), hb = opaque_s(hb_); (void)l; (void)hb;
                unsigned char* const ws = F.wsp(); const bf16_t* wmerge = (const bf16_t*)(ws + WS_WSMALL + (size_t)l * WSMALL_LAYER) + (size_t)N1 * D;
                pg8::Gemm g{(const bf16_t*)(ws + WS_ACT), wmerge, ACTC, 0}; pg8::StaticOrder S; S.init(TH, D, F.G, F.bid);
                pg8::EpiMerge E{(const unsigned char*)(ws + WS_G), (bf16_t*)(ws + WS_U)};
                pg8::gemm_phase<pg8::EpiMerge, pg8::StaticOrder>(F.lds, F.tid, g, S, E);
            }
            PH_END;
            if (SITE(5)) { LOCALF; const int l = opaque_s(l_), hb = opaque_s(hb_); (void)l; (void)hb;
                unsigned char* const ws = F.wsp(); const bf16_t* wo = (const bf16_t*)(ws + WS_WSMALL + (size_t)l * WSMALL_LAYER) + (size_t)N1 * D + (size_t)D * ACTC;
                pg8::Gemm g{(const bf16_t*)(ws + WS_U), wo, D / 2, 0}; pg8::StaticOrder S; S.init(TH, D, F.G, F.bid);
                pg8::EpiBf16 E{(bf16_t*)(ws + WS_HOUT), D, 1.f / (FP8_SX * FP8_SW13), 0};
                pg8::gemm_phase<pg8::EpiBf16, pg8::StaticOrder, true>(F.lds, F.tid, g, S, E);
            }
            PH_END;
            if (SITE(6)) { LOCALF; const int l = opaque_s(l_), hb = opaque_s(hb_); (void)l; (void)hb; phase_rf(F, l, hb, l_ > 0); }
            PH_END;
}
template <int l_> __device__ __forceinline__ void moe_phases(const Frame& F0, const XcdBarrier& bar, int& ph, const int lo, const int hi) {
        if (SITE(7)) { LOCALF; const int l = opaque_s(l_); (void)l; phase_rg(F); }
        PH_END;
        if (SITE(8)) { LOCALF; const int l = opaque_s(l_); (void)l;
            moe_tables(F, -1, -1, nullptr);
            const LAS int* pexp = (const LAS int*)(F.lds + PEXP_OFF);
            unsigned char* const ws = F.wsp();
            pg8::Gemm g{(const bf16_t*)(ws + WS_XS), (const bf16_t*)(ws + WS_W13), D / 2, (size_t)4096 * D};
            pg8::MoeOrder S{16, F.G, F.bid, __builtin_amdgcn_readfirstlane(pexp[NPMAX]), pexp, 4, 8};
            pg8::EpiSwiGLU E{ws + WS_H};
            pg8::gemm_phase<pg8::EpiSwiGLU, pg8::MoeOrder, true>(F.lds, F.tid, g, S, E);
        }
        PH_END;
        if (SITE(9)) { LOCALF; const int l = opaque_s(l_); (void)l;
            moe_tables(F, -1, -1, nullptr);
            const LAS int* pexp = (const LAS int*)(F.lds + PEXP_OFF);
            unsigned char* const ws = F.wsp();
            pg8::Gemm g{(const bf16_t*)(ws + WS_H), (const bf16_t*)(ws + WS_W2), FF / 2, (size_t)D * FF};
            pg8::MoeOrder S{4, F.G, F.bid, __builtin_amdgcn_readfirstlane(pexp[NPMAX]), pexp, 8, 4};
            pg8::EpiBf16 E{(bf16_t*)(ws + WS_XS), D, FP8_SY / (FP8_SH * FP8_SW2), 1};
            pg8::gemm_phase<pg8::EpiBf16, pg8::MoeOrder, true>(F.lds, F.tid, g, S, E);
        }
        PH_END;
        if (SITE(10)) { LOCALF; const int l = opaque_s(l_); (void)l; const int gw = F.bid * NWAVES + F.wave, NGW = F.G * NWAVES;
            phase_rj(F, l, l_ + 1 < DEPTH);
            if (l + 1 < DEPTH) { __syncthreads(); convert_moe(F, l + 1, gw, NGW); }
        }
        PH_END;
}
constexpr int PH_PER_HALF = 7, PH_PER_LAYER = NHALF * PH_PER_HALF + 4, NPHASES = 1 + DEPTH * PH_PER_LAYER;
__global__ void __launch_bounds__(NWAVES * 64, 2) trunk_fwd(Args args) {
    extern __shared__ __attribute__((aligned(16))) unsigned char lds[];
    Frame F0;
    F0.lds = (LAS unsigned char*)lds;
    F0.tid = threadIdx.x; F0.lane = F0.tid & 63; F0.wave = __builtin_amdgcn_readfirstlane(F0.tid >> 6);
    F0.G = gridDim.x; F0.bid = blockIdx.x; F0.in.p = (const LAS unsigned long long*)(F0.lds + PTAB_OFF);
    volatile LAS unsigned* MISC = (volatile LAS unsigned*)(F0.lds + MISC_OFF);
    for (int u = F0.tid; u < (LDS_BYTES - LDSCTL_OFF) / 4; u += NWAVES * 64) ((LAS unsigned*)(F0.lds + LDSCTL_OFF))[u] = 0u;
    __syncthreads();
    if (F0.tid < 25) ((LAS unsigned long long*)(F0.lds + PTAB_OFF))[F0.tid] = (unsigned long long)args.in[F0.tid];
    if (F0.tid == 25) ((LAS unsigned long long*)(F0.lds + PTAB_OFF))[25] = (unsigned long long)args.out;
    if (F0.tid == 26) ((LAS unsigned long long*)(F0.lds + PTAB_OFF))[26] = (unsigned long long)args.ws;
    __syncthreads();
    gu32* ctl = (gu32*)(args.ws + WS_CTL);
    XcdBarrier bar; bar.bar = (unsigned*)(ctl + CW_BAR); bar.x = 0; bar.st = nullptr;
    if (MK_ONE_LAUNCH) bar = xcd_barrier_post((unsigned*)(ctl + CW_BAR), MISC + 8, F0.tid == 0);
    const int lo = args.ph_lo, hi = args.ph_hi;
    int ph = 0;

    if (SITE(0)) { LOCALF; const int gw = F.bid * NWAVES + F.wave, NGW = F.G * NWAVES;
        convert_small(F, 0, gw, NGW); convert_small(F, 1, gw, NGW); convert_moe(F, 0, gw, NGW);
        { float* rotc = (float*)(F.wsp() + WS_ROT); float* rots = rotc + 2048 * 32;
          for (int i = F.bid * 512 + F.tid; i < 2048 * 32; i += F.G * 512) { const int t = i >> 5, j = i & 31; const float inv = powf(10000.f, -(float)j / 32.f); const float ang = (float)t * inv; rotc[i] = cosf(ang); rots[i] = sinf(ang); } }
        __syncthreads();
        if (F.bid < 192) ada_item(F, F.bid);
    }
    PH_END;

    half_phases<0, 0>(F0, bar, ph, lo, hi); half_phases<0, 1>(F0, bar, ph, lo, hi); moe_phases<0>(F0, bar, ph, lo, hi);
    half_phases<1, 0>(F0, bar, ph, lo, hi); half_phases<1, 1>(F0, bar, ph, lo, hi); moe_phases<1>(F0, bar, ph, lo, hi);
#undef PH_ON
#undef SITE
#undef PH_END
}

extern "C" void kernel_launch(void* const* d_in, const int* in_sizes, int n_in, void* d_out, int out_size, void* d_ws, size_t ws_size, hipStream_t stream) {
    static int grid = 0;
    if (grid == 0) {
        if (n_in != 25 || out_size != T * D || ws_size < WS_END) { fprintf(stderr, "kernel_launch: unexpected problem (n_in %d out %d ws %zu)\n", n_in, out_size, ws_size); grid = -1; return; }
        int dev = 0, cus = 0, per_cu = 0;
        if (hipGetDevice(&dev) != hipSuccess || hipDeviceGetAttribute(&cus, hipDeviceAttributeMultiprocessorCount, dev) != hipSuccess) { grid = -1; return; }
        if (hipFuncSetAttribute((const void*)trunk_fwd, hipFuncAttributeMaxDynamicSharedMemorySize, LDS_BYTES) != hipSuccess) { grid = -1; return; }
        if (hipOccupancyMaxActiveBlocksPerMultiprocessor(&per_cu, (const void*)trunk_fwd, NWAVES * 64, LDS_BYTES) != hipSuccess || per_cu < 1)
            fprintf(stderr, "kernel_launch: occupancy query reports %d\n", per_cu);
        (void)hipGetLastError();
        grid = cus;
        if (grid != 256) fprintf(stderr, "kernel_launch: %d CUs (built for 256)\n", grid);
    }
    if (grid < 0) return;
    if (hipMemsetAsync((char*)d_ws + WS_CTL, 0, CTL_ZERO_BYTES, stream) != hipSuccess) return;
    Args a{};
    for (int i = 0; i < 25; ++i) a.in[i] = (const float*)d_in[i];
    a.out = (float*)d_out; a.ws = (unsigned char*)d_ws;
#if MK_ONE_LAUNCH
    a.ph_lo = 0; a.ph_hi = NPHASES;
    hipLaunchKernelGGL(trunk_fwd, dim3(grid), dim3(NWAVES * 64), LDS_BYTES, stream, a);
#else
    for (int p = 0; p < NPHASES; ++p) { a.ph_lo = p; a.ph_hi = p + 1; hipLaunchKernelGGL(trunk_fwd, dim3(grid), dim3(NWAVES * 64), LDS_BYTES, stream, a); }
#endif
}
```

```cpp
#include <hip/hip_runtime.h>
#include <cstdio>
#include <cstdint>
#include <cmath>
#include <hip/hip_bf16.h>

#ifndef MK_ONE_LAUNCH
#define MK_ONE_LAUNCH 1
#endif

#define LAS __attribute__((address_space(3)))
#define GAS __attribute__((address_space(1)))
typedef unsigned short bf16_t;
typedef short bf16x8 __attribute__((ext_vector_type(8)));
typedef float f32x4 __attribute__((ext_vector_type(4)));
typedef float f32x2 __attribute__((ext_vector_type(2)));
typedef unsigned u32x4 __attribute__((ext_vector_type(4)));
typedef unsigned u32x2 __attribute__((ext_vector_type(2)));
typedef GAS unsigned gu32;

constexpr int D = 1024, BATCH = 32, SEQ = 2048, T = BATCH * SEQ, DEPTH = 2;
constexpr int NHALF = 2, BH = BATCH / NHALF, TH = BH * SEQ;
constexpr int ZC = 4096, ZP = 4160  , GC = 3072, N1 = ZC + GC, INC = 4104;
constexpr int ACTC = 1536;
constexpr int NE = 16, FF = 2048, NPMAX = 528, PMAX = NPMAX * 256;
constexpr int C_AVAL = 0, C_AGATE = 512, C_RQ = 1024, C_RK = 1280, C_RV = 1536, C_RG = 2048, C_FQ = 2560, C_FK = 3072, C_FV = 3584;
constexpr float LN_EPS = 1e-5f;
constexpr float DN_ALPHA = 1.41421356237309515f;
constexpr int NSEG = 512, SEGROWS = 128;

constexpr size_t MiB = 1u << 20;
constexpr size_t WS_CTL = 0, CTL_ZERO_BYTES = 1 * MiB;
constexpr size_t WS_ADA = 1 * MiB;
constexpr size_t WS_ROT = 3 * MiB;
constexpr size_t WS_RIDX = 4 * MiB;
constexpr size_t WS_RW = WS_RIDX + 512 * 1024;
constexpr size_t WS_RPOS = WS_RW + 512 * 1024;
constexpr size_t WS_SEGCNT = 6 * MiB;
constexpr size_t WS_FLOG = 8 * MiB;
constexpr size_t WS_WSMALL = 16 * MiB, WSMALL_LAYER = 19 * MiB;
constexpr size_t WS_W13 = 64 * MiB;
constexpr size_t WS_W2 = 192 * MiB;
constexpr size_t WS_U = 256 * MiB;
constexpr size_t WS_Z = 320 * MiB;
constexpr size_t WS_G = 592 * MiB;
constexpr size_t WS_ACT = 768 * MiB;
constexpr size_t WS_HOUT = 864 * MiB;
constexpr size_t WS_U2 = 928 * MiB;
constexpr size_t WS_XS = 256 * MiB;
constexpr size_t WS_H = 520 * MiB;
constexpr size_t WS_END = 1056 * MiB;
static_assert(WS_XS + (size_t)PMAX * 1024 * 2 <= WS_H && WS_H + (size_t)PMAX * 2048 * 2 <= WS_END && WS_U2 + (size_t)T * D * 2 <= WS_END, "ws map");
static_assert(WS_HOUT + (size_t)TH * D * 2 <= WS_U2 && WS_ACT + (size_t)TH * ACTC * 2 <= WS_HOUT && WS_G + (size_t)TH * GC <= WS_ACT && WS_Z + (size_t)TH * ZP * 2 <= WS_G, "ws map 2");
constexpr size_t WS_UF8_H1 = WS_U2 + 64 * MiB;
static_assert(WS_UF8_H1 + (size_t)TH * D <= WS_END, "ws map 3");
constexpr int CW_BAR = 4096;
constexpr int CW_QUEUE = 8192;

constexpr int RING_BYTES = 131072;
constexpr int LDSCTL_OFF = RING_BYTES, MISC_OFF = LDSCTL_OFF + 320;
constexpr int PEXP_OFF = LDSCTL_OFF + 1024;
constexpr int HIST_OFF = LDSCTL_OFF + 4096;
constexpr int LDS_BYTES = 147456;
constexpr int NWAVES = 8;

typedef float pk_f32x2_t __attribute__((ext_vector_type(2))); typedef __bf16 pk_bf16x2_t __attribute__((ext_vector_type(2)));
__device__ __forceinline__ unsigned pk2(float lo, float hi) { const pk_f32x2_t v = {lo, hi}; const pk_bf16x2_t b = __builtin_convertvector(v, pk_bf16x2_t); return __builtin_bit_cast(unsigned, b); }
__device__ __forceinline__ unsigned f2bf(float f) { return pk2(f, 0.f) & 0xffffu; }
__device__ __forceinline__ float bflo(unsigned w) { return __uint_as_float(w << 16); }
__device__ __forceinline__ float bfhi(unsigned w) { return __uint_as_float(w & 0xffff0000u); }
__device__ __forceinline__ float sigm(float x) { return __builtin_amdgcn_rcpf(1.f + __builtin_amdgcn_exp2f(-1.4426950408889634f * x)); }
#define SWZ_XOR(o) (0x1f | ((o) << 10))
__device__ __forceinline__ float swz_xor1(float v)  { return __int_as_float(__builtin_amdgcn_ds_swizzle(__float_as_int(v), SWZ_XOR(1))); }
__device__ __forceinline__ float swz_xor2(float v)  { return __int_as_float(__builtin_amdgcn_ds_swizzle(__float_as_int(v), SWZ_XOR(2))); }
__device__ __forceinline__ float swz_xor4(float v)  { return __int_as_float(__builtin_amdgcn_ds_swizzle(__float_as_int(v), SWZ_XOR(4))); }
__device__ __forceinline__ float swz_xor8(float v)  { return __int_as_float(__builtin_amdgcn_ds_swizzle(__float_as_int(v), SWZ_XOR(8))); }
__device__ __forceinline__ float swz_xor16(float v) { return __int_as_float(__builtin_amdgcn_ds_swizzle(__float_as_int(v), SWZ_XOR(16))); }
__device__ __forceinline__ float sum_xor32(float v) { auto rr = __builtin_amdgcn_permlane32_swap(__float_as_uint(v), __float_as_uint(v), false, false); return __uint_as_float(rr[0]) + __uint_as_float(rr[1]); }
__device__ __forceinline__ float max_xor32(float v) { auto rr = __builtin_amdgcn_permlane32_swap(__float_as_uint(v), __float_as_uint(v), false, false); return fmaxf(__uint_as_float(rr[0]), __uint_as_float(rr[1])); }
__device__ __forceinline__ float wave_sum(float v) {
    v += swz_xor1(v); v += swz_xor2(v); v += swz_xor4(v); v += swz_xor8(v); v += swz_xor16(v); return sum_xor32(v);
}
template <int N> __device__ __forceinline__ void wave_sum_n(float (&v)[N]) {
    float t[N];
#pragma unroll
    for (int i = 0; i < N; ++i) t[i] = swz_xor1(v[i]);
#pragma unroll
    for (int i = 0; i < N; ++i) v[i] += t[i];
#pragma unroll
    for (int i = 0; i < N; ++i) t[i] = swz_xor2(v[i]);
#pragma unroll
    for (int i = 0; i < N; ++i) v[i] += t[i];
#pragma unroll
    for (int i = 0; i < N; ++i) t[i] = swz_xor4(v[i]);
#pragma unroll
    for (int i = 0; i < N; ++i) v[i] += t[i];
#pragma unroll
    for (int i = 0; i < N; ++i) t[i] = swz_xor8(v[i]);
#pragma unroll
    for (int i = 0; i < N; ++i) v[i] += t[i];
#pragma unroll
    for (int i = 0; i < N; ++i) t[i] = swz_xor16(v[i]);
#pragma unroll
    for (int i = 0; i < N; ++i) v[i] += t[i];
#pragma unroll
    for (int i = 0; i < N; ++i) v[i] = sum_xor32(v[i]);
}
__device__ __forceinline__ float rs16(const float (&v)[16], int lane) {
    float a[8];
#pragma unroll
    for (int i = 0; i < 8; ++i) { auto rr = __builtin_amdgcn_permlane32_swap(__float_as_uint(v[i]), __float_as_uint(v[8 + i]), false, false);
        a[i] = __uint_as_float(rr[0]) + __uint_as_float(rr[1]); }
    const bool b4 = (lane & 16) != 0, b3 = (lane & 8) != 0, b2 = (lane & 4) != 0;
    float b[4];
#pragma unroll
    for (int i = 0; i < 4; ++i) { const float mine = b4 ? a[4 + i] : a[i], other = b4 ? a[i] : a[4 + i]; b[i] = mine + swz_xor16(other); }
    float c[2];
#pragma unroll
    for (int i = 0; i < 2; ++i) { const float mine = b3 ? b[2 + i] : b[i], other = b3 ? b[i] : b[2 + i]; c[i] = mine + swz_xor8(other); }
    float d = (b2 ? c[1] : c[0]) + swz_xor4(b2 ? c[0] : c[1]);
    d += swz_xor1(d); d += swz_xor2(d);
    return d;
}
__device__ __forceinline__ float lane_bcast(float x, int srclane) { return __int_as_float(__builtin_amdgcn_readlane(__float_as_int(x), srclane)); }
__device__ __forceinline__ int opaque_v(int x) { asm volatile("" : "+v"(x)); return x; }
__device__ __forceinline__ int opaque_s(int x) { asm volatile("" : "+s"(x)); return x; }
typedef int i32x8 __attribute__((ext_vector_type(8)));
__device__ __forceinline__ f32x4 bf4_to_f32(u32x2 p) { return (f32x4){bflo(p.x), bfhi(p.x), bflo(p.y), bfhi(p.y)}; }
__device__ __forceinline__ unsigned pk4_fp8(float a, float b, float c, float d) {
    a = __builtin_amdgcn_fmed3f(a, -448.f, 448.f); b = __builtin_amdgcn_fmed3f(b, -448.f, 448.f); c = __builtin_amdgcn_fmed3f(c, -448.f, 448.f); d = __builtin_amdgcn_fmed3f(d, -448.f, 448.f);
    int r = 0; r = __builtin_amdgcn_cvt_pk_fp8_f32(a, b, r, false); r = __builtin_amdgcn_cvt_pk_fp8_f32(c, d, r, true); return (unsigned)r; }
__device__ __forceinline__ unsigned pk4_fp8_nc(float a, float b, float c, float d) { int r = 0; r = __builtin_amdgcn_cvt_pk_fp8_f32(a, b, r, false); r = __builtin_amdgcn_cvt_pk_fp8_f32(c, d, r, true); return (unsigned)r; }
constexpr float FP8_SX = 16.f, FP8_SH = 16.f, FP8_SW13 = 64.f, FP8_SW2 = 128.f, FP8_SY = 64.f, FP8_SG = 256.f;
#define LDS_WAIT() asm volatile("s_waitcnt lgkmcnt(0)" ::: "memory")
#define VM_WAIT() asm volatile("s_waitcnt vmcnt(0)" ::: "memory")
#define LDS_BARRIER() do { asm volatile("s_waitcnt lgkmcnt(0)" ::: "memory"); __builtin_amdgcn_s_barrier(); asm volatile("" ::: "memory"); } while (0)
#define RLX_AGENT __ATOMIC_RELAXED, __HIP_MEMORY_SCOPE_AGENT

namespace pg8 {
constexpr int BM = 256, BK = 64, HALF = 128, HTB = HALF * BK * 2, STAGE_BYTES = 8 * HTB, NXCD = 8, WGM = 8;
__host__ __device__ __forceinline__ int lds_byte(int r, int c) { const int st = (r >> 4) * 2 + (c >> 5), rr = r & 15, cc = c & 31, ob = rr * 64 + cc * 2; return st * 1024 + (ob ^ (((ob >> 9) & 1) << 5)); }
__host__ __device__ __forceinline__ void stage_rc(int b, int& R, int& C) { const int st = b / 1024, sb = b % 1024, swz = sb ^ (((sb >> 9) & 1) << 5); R = (st >> 1) * 16 + swz / 64; C = (st & 1) * 32 + (swz % 64) / 2; }
__host__ __device__ __forceinline__ int perm32(int rho) { const int n = rho >> 4, i = rho & 15; return 8 * (i >> 2) + 4 * n + (i & 3); }

typedef int i32x4_t __attribute__((ext_vector_type(4)));
struct Unit { int pm, pn, e; };
struct Gemm { const bf16_t* A; const bf16_t* Bt; int K; size_t bstride; };

struct StaticOrder {
    int nM, nN, nwg, G, c; int pn_off = 0;
    __device__ void init(int M, int N, int G_, int c_) { nM = M / BM; nN = N / BM; nwg = nM * nN; G = G_; c = c_; }
    __device__ bool next(int i, Unit& u) const {
        const long L = (long)i * G + c; if (L >= nwg) return false;
        int wgid = (int)L; { const int q = nwg / NXCD, r = nwg % NXCD, xcd = wgid % NXCD, off = wgid / NXCD; wgid = (xcd < r ? xcd * (q + 1) : r * (q + 1) + (xcd - r) * q) + off; }
        const int nig = WGM * nN, gid = wgid / nig, fm = gid * WGM, gsz = (nM - fm) < WGM ? (nM - fm) : WGM;
        u.pm = fm + ((wgid % nig) % gsz); u.pn = (wgid % nig) / gsz + pn_off; u.e = 0; return true;
    }
};
struct MoeOrder {
    int nN, G, c, np; const LAS int* pexp; int PG, NG;
    __device__ bool next(int i, Unit& u) const {
        const int xcd = c & 7, k = c >> 3, R = i * 8 + xcd, ngrp = nN / NG, s_ = R / ngrp, pg = R % ngrp;
        const int panel = s_ * PG + (k % PG); if (panel >= np) return false;
        u.pm = panel; u.pn = pg * NG + (k / PG); u.e = __builtin_amdgcn_readfirstlane(pexp[u.pm]); return true;
    }
};

__device__ __forceinline__ unsigned cvt_pk_bf16(float lo, float hi) { unsigned r; asm volatile("v_cvt_pk_bf16_f32 %0, %1, %2" : "=v"(r) : "v"(lo), "v"(hi)); return r; }

struct EpiZG {
    static constexpr bool PERM = true, HOOK = false;
    bf16_t* Z; bf16_t* Gt; const float* bgate; int pn_add; float ginv;
    __device__ __forceinline__ void operator()(const f32x4 (&acc)[2][2][4][2], const Unit& u, int wr, int wc, int fr, int fq) const {
        const int upn = u.pn + pn_add;
        const bool isg = upn >= 16; const float qsc = (upn == 10 || upn == 11) ? 0.125f * 1.4426950408889634f : 1.f;
        const int row0 = u.pm * BM + wr * 64 + fr; const int colt = (isg ? upn - 16 : upn) * BM;
        const int col0 = colt + wc * 32 + 8 * fq;
        f32x4 bv[2][2];
#pragma unroll
        for (int bj = 0; bj < 2; ++bj)
#pragma unroll
            for (int n = 0; n < 2; ++n) bv[bj][n] = isg ? *(const f32x4*)(bgate + col0 + bj * HALF + 4 * n) : (f32x4){0.f, 0.f, 0.f, 0.f};
#pragma unroll
        for (int ai = 0; ai < 2; ++ai)
#pragma unroll
            for (int m = 0; m < 4; ++m) { const size_t row = (size_t)(row0 + ai * HALF + m * 16);
#pragma unroll
                for (int bj = 0; bj < 2; ++bj) { f32x4 v0 = acc[ai][bj][m][0], v1 = acc[ai][bj][m][1];
                    if (isg) { v0 = v0 * ginv + bv[bj][0]; v1 = v1 * ginv + bv[bj][1];
#pragma unroll
                        for (int q = 0; q < 4; ++q) { v0[q] = fmaxf(sigm(v0[q]) * FP8_SG, 0.002f); v1[q] = fmaxf(sigm(v1[q]) * FP8_SG, 0.002f); }
                        *(u32x2*)((unsigned char*)Gt + row * GC + col0 + bj * HALF) = (u32x2){pk4_fp8_nc(v0[0], v0[1], v0[2], v0[3]), pk4_fp8_nc(v1[0], v1[1], v1[2], v1[3])}; }
                    else { v0 = v0 * (qsc * ginv); v1 = v1 * (qsc * ginv);
                        u32x4 w; w.x = cvt_pk_bf16(v0[0], v0[1]); w.y = cvt_pk_bf16(v0[2], v0[3]); w.z = cvt_pk_bf16(v1[0], v1[1]); w.w = cvt_pk_bf16(v1[2], v1[3]);
                        *(u32x4*)(Z + row * ZP + col0 + bj * HALF) = w; } } }
    }
};
struct EpiBf16 {
    static constexpr bool PERM = true, HOOK = false;
    bf16_t* O; int ldc; float scale; int fp8out;
    __device__ __forceinline__ void operator()(const f32x4 (&acc)[2][2][4][2], const Unit& u, int wr, int wc, int fr, int fq) const {
        const int row0 = u.pm * BM + wr * 64 + fr; const int col0 = u.pn * BM + wc * 32 + 8 * fq;
        if (fp8out) {
#pragma unroll
            for (int ai = 0; ai < 2; ++ai)
#pragma unroll
                for (int m = 0; m < 4; ++m) { unsigned char* rowp = (unsigned char*)O + (size_t)(row0 + ai * HALF + m * 16) * ldc + col0;
#pragma unroll
                    for (int bj = 0; bj < 2; ++bj) { const f32x4 v0 = acc[ai][bj][m][0] * scale, v1 = acc[ai][bj][m][1] * scale;
                        *(u32x2*)(rowp + bj * HALF) = (u32x2){pk4_fp8(v0[0], v0[1], v0[2], v0[3]), pk4_fp8(v1[0], v1[1], v1[2], v1[3])}; } }
            return; }
#pragma unroll
        for (int ai = 0; ai < 2; ++ai)
#pragma unroll
            for (int m = 0; m < 4; ++m) { bf16_t* rowp = O + (size_t)(row0 + ai * HALF + m * 16) * ldc + col0;
#pragma unroll
                for (int bj = 0; bj < 2; ++bj) { const f32x4 v0 = acc[ai][bj][m][0] * scale, v1 = acc[ai][bj][m][1] * scale;
                    u32x4 w; w.x = cvt_pk_bf16(v0[0], v0[1]); w.y = cvt_pk_bf16(v0[2], v0[3]); w.z = cvt_pk_bf16(v1[0], v1[1]); w.w = cvt_pk_bf16(v1[2], v1[3]);
                    *(u32x4*)(rowp + bj * HALF) = w; } }
    }
};
struct EpiSwiGLU {
    static constexpr bool PERM = true, HOOK = false;
    unsigned char* Hb;
    __device__ __forceinline__ void operator()(const f32x4 (&acc)[2][2][4][2], const Unit& u, int wr, int wc, int fr, int fq) const {
        const int row0 = u.pm * BM + wr * 64 + fr; const int col0 = u.pn * HALF + wc * 32 + 8 * fq;
        constexpr float INV = 1.f / (FP8_SX * FP8_SW13);
#pragma unroll
        for (int ai = 0; ai < 2; ++ai)
#pragma unroll
            for (int m = 0; m < 4; ++m) { unsigned char* rowp = Hb + (size_t)(row0 + ai * HALF + m * 16) * FF + col0;
                f32x4 v0 = acc[ai][0][m][0] * INV, v1 = acc[ai][0][m][1] * INV; const f32x4 g0 = acc[ai][1][m][0] * (INV * FP8_SH), g1 = acc[ai][1][m][1] * (INV * FP8_SH);
#pragma unroll
                for (int q = 0; q < 4; ++q) { v0[q] = v0[q] * sigm(v0[q]) * g0[q]; v1[q] = v1[q] * sigm(v1[q]) * g1[q]; }
                *(u32x2*)rowp = (u32x2){pk4_fp8(v0[0], v0[1], v0[2], v0[3]), pk4_fp8(v1[0], v1[1], v1[2], v1[3])}; }
    }
};
struct EpiMerge {
    static constexpr bool PERM = true, HOOK = true;
    const unsigned char* Gb; bf16_t* Mo;
    __device__ __forceinline__ void hook(f32x4 (&acc)[2][2][4][2], const Unit& u, int j, int wr, int wc, int fr, int fq) const {
        const int row0 = opaque_v(u.pm * BM + wr * 64 + fr); const int col0 = opaque_v(u.pn * BM + wc * 32 + 8 * fq);
#pragma unroll
        for (int ai = 0; ai < 2; ++ai) {
            u32x2 ga[4][2], gb[4][2];
#pragma unroll
            for (int m = 0; m < 4; ++m)
#pragma unroll
                for (int bj = 0; bj < 2; ++bj) { const unsigned char* p = Gb + (size_t)(row0 + ai * HALF + m * 16) * GC + col0 + bj * HALF;
                    ga[m][bj] = *(const u32x2*)(p + (j - 1) * D); gb[m][bj] = *(const u32x2*)(p + j * D); }
#pragma unroll
            for (int m = 0; m < 4; ++m)
#pragma unroll
                for (int bj = 0; bj < 2; ++bj) {
#pragma unroll
                    for (int q = 0; q < 2; ++q) { const int a = (int)ga[m][bj][q], b = (int)gb[m][bj][q];
                        const f32x2 alo = __builtin_amdgcn_cvt_pk_f32_fp8(a, false), ahi = __builtin_amdgcn_cvt_pk_f32_fp8(a, true), blo = __builtin_amdgcn_cvt_pk_f32_fp8(b, false), bhi = __builtin_amdgcn_cvt_pk_f32_fp8(b, true);
                        acc[ai][bj][m][q][0] *= alo.x * __builtin_amdgcn_rcpf(blo.x); acc[ai][bj][m][q][1] *= alo.y * __builtin_amdgcn_rcpf(blo.y);
                        acc[ai][bj][m][q][2] *= ahi.x * __builtin_amdgcn_rcpf(bhi.x); acc[ai][bj][m][q][3] *= ahi.y * __builtin_amdgcn_rcpf(bhi.y); } }
            asm volatile("" ::: "memory");
        }
    }
    __device__ __forceinline__ void operator()(const f32x4 (&acc)[2][2][4][2], const Unit& u, int wr, int wc, int fr, int fq) const {
        const int row0 = u.pm * BM + wr * 64 + fr; const int col0 = u.pn * BM + wc * 32 + 8 * fq;
        constexpr float IG = FP8_SX / FP8_SG;
#pragma unroll
        for (int ai = 0; ai < 2; ++ai) {
            u32x2 gc[4][2];
#pragma unroll
            for (int m = 0; m < 4; ++m)
#pragma unroll
                for (int bj = 0; bj < 2; ++bj) gc[m][bj] = *(const u32x2*)(Gb + (size_t)(row0 + ai * HALF + m * 16) * GC + 2 * D + col0 + bj * HALF);
#pragma unroll
            for (int m = 0; m < 4; ++m)
#pragma unroll
                for (int bj = 0; bj < 2; ++bj) { const f32x4 v0 = acc[ai][bj][m][0] * IG, v1 = acc[ai][bj][m][1] * IG;
                    const f32x2 g0 = __builtin_amdgcn_cvt_pk_f32_fp8((int)gc[m][bj].x, false), g1 = __builtin_amdgcn_cvt_pk_f32_fp8((int)gc[m][bj].x, true), g2 = __builtin_amdgcn_cvt_pk_f32_fp8((int)gc[m][bj].y, false), g3 = __builtin_amdgcn_cvt_pk_f32_fp8((int)gc[m][bj].y, true);
                    *(u32x2*)((unsigned char*)Mo + (size_t)(row0 + ai * HALF + m * 16) * D + col0 + bj * HALF) = (u32x2){pk4_fp8(v0[0] * g0.x, v0[1] * g0.y, v0[2] * g1.x, v0[3] * g1.y), pk4_fp8(v1[0] * g2.x, v1[1] * g2.y, v1[2] * g3.x, v1[3] * g3.y)}; }
        }
    }
};

template <class Epi, class Sched, bool FP8 = false>
__device__ __forceinline__ void gemm_phase(LAS unsigned char* lds, const int tid_, const Gemm g, const Sched& S, const Epi& E) {
    const int tid = opaque_v(tid_), wid = __builtin_amdgcn_readfirstlane(tid >> 6), lane = tid & 63, wr = wid >> 2, wc = wid & 3, fr = lane & 15, fq = lane >> 4;
    const int K = g.K, nt = K / BK;
    unsigned voffA[2], voffB[2];
#pragma unroll
    for (int i = 0; i < 2; ++i) { int R, C; stage_rc(tid * 16 + i * 8192, R, C); const int Rb = Epi::PERM ? ((R & ~31) + perm32(R & 31)) : R;
        voffA[i] = (unsigned)(R * K + C) * 2u; voffB[i] = (unsigned)(Rb * K + C) * 2u; }
    const size_t kstep = (size_t)(BK * 2);
    const size_t hstep = (size_t)HALF * K * 2;
    const size_t tstep = 2 * hstep;
    const unsigned ldsw = (unsigned)wid * 1024u;
    const int aoff = lds_byte(wr * 64 + fr, fq * 8), boff = lds_byte(wc * 32 + fr, fq * 8);
#define PG8_SA(b, h) (((b) * 2 + (h)) * HTB)
#define PG8_SB(b, h) ((4 + (b) * 2 + (h)) * HTB)
#define PG8_STAGE(bufoff, gbase, voff) do { _Pragma("unroll") for (int _i = 0; _i < 2; ++_i) \
        __builtin_amdgcn_global_load_lds((const unsigned*)((const char*)(gbase) + (voff)[_i]), (LAS unsigned*)(lds + (bufoff) + ldsw + _i * 8192), 16, 0, 0); } while (0)
#define PG8_LDA(dst, b, h) do { _Pragma("unroll") for (int m = 0; m < 4; ++m) _Pragma("unroll") for (int k = 0; k < 2; ++k) dst[m][k] = *(const LAS bf16x8*)(lds + PG8_SA(b, h) + aoff + m * 2048 + k * 1024); } while (0)
#define PG8_LDB(dst, b, h) do { _Pragma("unroll") for (int n = 0; n < 2; ++n) _Pragma("unroll") for (int k = 0; k < 2; ++k) dst[n][k] = *(const LAS bf16x8*)(lds + PG8_SB(b, h) + boff + n * 2048 + k * 1024); } while (0)
#define PG8_CAT(lo, hi) __builtin_shufflevector(__builtin_bit_cast(i32x4_t, lo), __builtin_bit_cast(i32x4_t, hi), 0, 1, 2, 3, 4, 5, 6, 7)
#define PG8_MMA(ai, bj, At, Bt) do { __builtin_amdgcn_s_setprio(1); _Pragma("unroll") for (int m = 0; m < 4; ++m) _Pragma("unroll") for (int n = 0; n < 2; ++n) { \
        if constexpr (FP8) { const i32x8 b8_ = PG8_CAT(Bt[n][0], Bt[n][1]), a8_ = PG8_CAT(At[m][0], At[m][1]); asm volatile("v_mfma_f32_16x16x128_f8f6f4 %0, %1, %2, %0" : "+v"(acc[ai][bj][m][n]) : "v"(b8_), "v"(a8_)); } \
        else { _Pragma("unroll") for (int k = 0; k < 2; ++k) acc[ai][bj][m][n] = __builtin_amdgcn_mfma_f32_16x16x32_bf16(Bt[n][k], At[m][k], acc[ai][bj][m][n], 0, 0, 0); } } __builtin_amdgcn_s_setprio(0); } while (0)
#define PG8_WAIT_V(n) asm volatile("s_waitcnt vmcnt(" #n ")" ::: "memory")
#define PG8_WAIT_L(n) asm volatile("s_waitcnt lgkmcnt(" #n ")" ::: "memory")
#define PG8_BAR __builtin_amdgcn_s_barrier()
#define PG8_SCHED __builtin_amdgcn_sched_barrier(0)
    Unit cur, nxt; int ui = 0;
    if (!S.next(0, cur)) return;
    f32x4 acc[2][2][4][2];
#pragma unroll
    for (int a = 0; a < 2; ++a)
#pragma unroll
        for (int b = 0; b < 2; ++b)
#pragma unroll
            for (int m = 0; m < 4; ++m)
#pragma unroll
                for (int n = 0; n < 2; ++n) acc[a][b][m][n] = (f32x4){0.f, 0.f, 0.f, 0.f};
    bf16x8 At[4][2], B0[2][2], B1[2][2];
    const char* cA = (const char*)g.A + (size_t)cur.pm * tstep; const char* cB = (const char*)g.Bt + (size_t)cur.e * g.bstride + (size_t)cur.pn * tstep;
    PG8_STAGE(PG8_SB(0, 0), cB, voffB); PG8_STAGE(PG8_SB(0, 1), cB + hstep, voffB); PG8_STAGE(PG8_SA(0, 0), cA, voffA); PG8_STAGE(PG8_SA(0, 1), cA + hstep, voffA);
    if (wr == 1) PG8_BAR;
    PG8_WAIT_V(2); PG8_BAR;
    PG8_STAGE(PG8_SB(1, 0), cB + kstep, voffB); PG8_STAGE(PG8_SA(1, 0), cA + kstep, voffA); PG8_STAGE(PG8_SB(1, 1), cB + hstep + kstep, voffB);
    PG8_WAIT_V(6); PG8_BAR;
    for (;;) {
        const bool has_next = S.next(ui + 1, nxt);
        const char* nA = has_next ? (const char*)g.A + (size_t)nxt.pm * tstep : cA;
        const char* nB = has_next ? (const char*)g.Bt + (size_t)nxt.e * g.bstride + (size_t)nxt.pn * tstep : cB;
        for (int t = 0; t < nt; t += 2) {
            if constexpr (Epi::HOOK) { if (t == 8 || t == 16) { E.hook(acc, cur, t >> 3, wr, wc, fr, fq); } }
            const bool last = (t == nt - 2);
            const char* a1 = cA + (size_t)(t + 1) * kstep;
            const char* a2 = last ? nA : cA + (size_t)(t + 2) * kstep; const char* b2 = last ? nB : cB + (size_t)(t + 2) * kstep;
            const char* a3 = a2 + kstep; const char* b3 = b2 + kstep;
            PG8_LDB(B0, 0, 0); PG8_LDB(B1, 0, 1); PG8_SCHED; PG8_LDA(At, 0, 0); PG8_STAGE(PG8_SA(1, 1), a1 + hstep, voffA);
            PG8_WAIT_V(8); PG8_WAIT_L(0); PG8_BAR; PG8_MMA(0, 0, At, B0); PG8_MMA(0, 1, At, B1); PG8_BAR; PG8_SCHED;
            PG8_LDA(At, 0, 1); PG8_STAGE(PG8_SB(0, 0), b2, voffB); PG8_STAGE(PG8_SB(0, 1), b2 + hstep, voffB); PG8_STAGE(PG8_SA(0, 0), a2, voffA);
            PG8_WAIT_V(8); PG8_WAIT_L(0); PG8_BAR; PG8_MMA(1, 0, At, B0); PG8_MMA(1, 1, At, B1); PG8_BAR; PG8_SCHED;
            PG8_LDB(B0, 1, 0); PG8_LDB(B1, 1, 1); PG8_SCHED; PG8_LDA(At, 1, 0); PG8_STAGE(PG8_SA(0, 1), a2 + hstep, voffA);
            PG8_WAIT_V(8); PG8_WAIT_L(0); PG8_BAR; PG8_MMA(0, 0, At, B0); PG8_MMA(0, 1, At, B1); PG8_BAR; PG8_SCHED;
            PG8_LDA(At, 1, 1); PG8_STAGE(PG8_SB(1, 0), b3, voffB); PG8_STAGE(PG8_SB(1, 1), b3 + hstep, voffB); PG8_STAGE(PG8_SA(1, 0), a3, voffA);
            PG8_WAIT_V(8); PG8_WAIT_L(0); PG8_BAR; PG8_MMA(1, 0, At, B0); PG8_MMA(1, 1, At, B1); PG8_BAR; PG8_SCHED;
        }
        if constexpr (FP8) {
#define PG8_ACC4(a, b, m) "+v"(acc[a][b][m][0]), "+v"(acc[a][b][m][1])
            asm volatile("s_nop 15\n\ts_nop 7" : PG8_ACC4(0, 0, 0), PG8_ACC4(0, 0, 1), PG8_ACC4(0, 0, 2), PG8_ACC4(0, 0, 3), PG8_ACC4(0, 1, 0), PG8_ACC4(0, 1, 1), PG8_ACC4(0, 1, 2), PG8_ACC4(0, 1, 3) :: "memory");
            asm volatile("" : PG8_ACC4(1, 0, 0), PG8_ACC4(1, 0, 1), PG8_ACC4(1, 0, 2), PG8_ACC4(1, 0, 3), PG8_ACC4(1, 1, 0), PG8_ACC4(1, 1, 1), PG8_ACC4(1, 1, 2), PG8_ACC4(1, 1, 3) :: "memory");
#undef PG8_ACC4
        }
        if (wr == 0) PG8_BAR;
        E(acc, cur, wr, wc, fr, fq);
        if (!has_next) break;
#pragma unroll
        for (int a = 0; a < 2; ++a)
#pragma unroll
            for (int b = 0; b < 2; ++b)
#pragma unroll
                for (int m = 0; m < 4; ++m)
#pragma unroll
                    for (int n = 0; n < 2; ++n) acc[a][b][m][n] = (f32x4){0.f, 0.f, 0.f, 0.f};
        cur = nxt; cA = nA; cB = nB; ++ui;
        if (wr == 1) PG8_BAR;
    }
    PG8_WAIT_V(0);
    PG8_BAR;
#undef PG8_SA
#undef PG8_SB
#undef PG8_STAGE
#undef PG8_LDA
#undef PG8_LDB
#undef PG8_MMA
#undef PG8_CAT
#undef PG8_WAIT_V
#undef PG8_WAIT_L
#undef PG8_BAR
#undef PG8_SCHED
}
}

#define XB_TMO      128
#define XB_XCNT(j)  (256  + 64 * (j))
#define XB_XSUB(j)  (1280 + 64 * (j))
#define XB_XGEN(j)  (2304 + 64 * (j))
#define XB_TOP      3328
#define XB_TOPGEN   3392
#define XCD_BAR_WORDS 3456
#define XB_SPIN_CAP (1u << 18)
__device__ __forceinline__ unsigned xb_ld(unsigned* p)              { return __hip_atomic_load(p, __ATOMIC_RELAXED, __HIP_MEMORY_SCOPE_AGENT); }
__device__ __forceinline__ unsigned xb_add(unsigned* p, unsigned v) { return __hip_atomic_fetch_add(p, v, __ATOMIC_RELAXED, __HIP_MEMORY_SCOPE_AGENT); }
__device__ __forceinline__ unsigned xb_xcc_id() { return (unsigned)__builtin_amdgcn_s_getreg((3 << 11) | 20) & 0xFu; }
#define XB_SPIN(cond, bar) do { unsigned _sp = 0; while (cond) { __builtin_amdgcn_s_sleep(1); \
    if ((++_sp & 255u) == 0u) { if (xb_ld(&(bar)[XB_TMO])) break; if (_sp > XB_SPIN_CAP) { atomicAdd(&(bar)[XB_TMO], 1u); break; } } } } while (0)
struct XcdBarrier { unsigned* bar; unsigned x; volatile LAS unsigned* st; };
__device__ __forceinline__ XcdBarrier xcd_barrier_post(unsigned* bar, volatile LAS unsigned* st, const bool t0  ) {
    XcdBarrier b; b.bar = bar; b.x = xb_xcc_id(); b.st = st;
    if (t0) (void)xb_add(&bar[XB_XCNT(b.x)], 1u);
    return b;
}
__device__ __forceinline__ void xcd_barrier_complete(unsigned* bar, unsigned x, unsigned& nloc, unsigned& nx) {
    const unsigned G = gridDim.x * gridDim.y * gridDim.z;
    unsigned sum, cnt, mine, sp = 0u;
    for (;;) {
        sum = 0u; cnt = 0u; mine = 0u;
#pragma unroll
        for (unsigned j = 0; j < 16; ++j) { const unsigned c = xb_ld(&bar[XB_XCNT(j)]); sum += c; cnt += (c > 0u) ? 1u : 0u; mine = (j == x) ? c : mine; }
        if (sum == G) break;
        __builtin_amdgcn_s_sleep(1);
        if ((++sp & 255u) == 0u) { if (xb_ld(&bar[XB_TMO])) break; if (sp > XB_SPIN_CAP) { atomicAdd(&bar[XB_TMO], 1u); break; } }
    }
    nloc = mine > 0u ? mine : 1u; nx = cnt > 0u ? cnt : 1u;
}
__device__ __forceinline__ void xcd_barrier(const XcdBarrier& b, const bool t0  ) {
    asm volatile("s_waitcnt vmcnt(0)" ::: "memory");
    __syncthreads();
    if (t0) {
        unsigned* bar = b.bar; asm volatile("" : "+s"(bar));
        __builtin_amdgcn_s_waitcnt(0);
        unsigned nloc = b.st[0], nx = b.st[1];
        if (nloc == 0u) { xcd_barrier_complete(bar, b.x, nloc, nx); b.st[0] = nloc; b.st[1] = nx; }
        const unsigned old = xb_add(&bar[XB_XSUB(b.x)], 1u);
        const unsigned gen = old / nloc;
        if (old + 1u == (gen + 1u) * nloc) {
            __builtin_amdgcn_fence(__ATOMIC_RELEASE, "agent");
            asm volatile("s_waitcnt vmcnt(0)" ::: "memory");
            const unsigned og = xb_add(&bar[XB_TOP], 1u);
            const unsigned tg = og / nx;
            if (og + 1u == (tg + 1u) * nx) xb_add(&bar[XB_TOPGEN], 1u);
            else XB_SPIN(xb_ld(&bar[XB_TOPGEN]) == tg, bar);
            __builtin_amdgcn_fence(__ATOMIC_ACQUIRE, "agent");
            xb_add(&bar[XB_XGEN(b.x)], 1u);
            asm volatile("s_waitcnt vmcnt(0)" ::: "memory");
        } else {
            XB_SPIN(xb_ld(&bar[XB_XGEN(b.x)]) == gen, bar);
            __builtin_amdgcn_fence(__ATOMIC_ACQUIRE, "agent");
            asm volatile("s_waitcnt vmcnt(0)" ::: "memory");
        }
    }
    __syncthreads();
}

struct Args { const float* in[25]; float* out; unsigned char* ws; int ph_lo, ph_hi; };
constexpr int PTAB_OFF = LDSCTL_OFF + 512;
struct InTab { const LAS unsigned long long* p;
    __device__ __forceinline__ const float* operator[](int i) const { const unsigned long long v = p[i];
        const unsigned lo = __builtin_amdgcn_readfirstlane((unsigned)v), hi = __builtin_amdgcn_readfirstlane((unsigned)(v >> 32)); return (const float*)(const GAS float*)(((unsigned long long)hi << 32) | lo); } };
struct Frame {
    LAS unsigned char* lds;
    int tid, lane, wave, G, bid;
    InTab in;
    __device__ __forceinline__ float* outp() const { return (float*)in[25]; }
    __device__ __forceinline__ unsigned char* wsp() const { return (unsigned char*)in[26]; }
};
enum { I_X = 0, I_C, I_WADA, I_BADA, I_WIN, I_CONVW, I_CONVB, I_CLNG, I_CLNB, I_BFORGET, I_WCONVOUT, I_WRETOUT, I_WFOXOUT, I_WGATE, I_BGATE, I_WOUT, I_LN1G, I_LN1B,
       I_WROUTER, I_BROUTER, I_W1, I_W3, I_W2, I_LN2G, I_LN2B };

__device__ __forceinline__ void transpose_item(const float* W, int ldw, int k0, int n0, bf16_t* dst, int dpitch, int drow0, int dk0, LAS float* scr, int lane) {
#pragma unroll 8
    for (int i = 0; i < 32; ++i) { const int kk = 2 * i + (lane >> 5); scr[kk * 33 + (lane & 31)] = W[(size_t)(k0 + kk) * ldw + n0 + (lane & 31)]; }
    LDS_WAIT(); asm volatile("" ::: "memory");
    const int c = lane & 7;
#pragma unroll
    for (int j = 0; j < 4; ++j) { const int n = (lane >> 3) + 8 * j; const LAS float* s = scr + (8 * c) * 33 + n;
        u32x4 o; o.x = pk2(s[0 * 33], s[1 * 33]); o.y = pk2(s[2 * 33], s[3 * 33]); o.z = pk2(s[4 * 33], s[5 * 33]); o.w = pk2(s[6 * 33], s[7 * 33]);
        *(u32x4*)(dst + (size_t)(drow0 + n) * dpitch + dk0 + k0 + 8 * c) = o; }
    LDS_WAIT(); asm volatile("" ::: "memory");
}
__device__ __forceinline__ void transpose_item_fp8(const float* W, int ldw, int k0, int n0, unsigned char* dst, int dpitch, int drow0, int dk0, LAS float* scr, int lane, float scale) {
#pragma unroll 8
    for (int i = 0; i < 32; ++i) { const int kk = 2 * i + (lane >> 5); scr[kk * 33 + (lane & 31)] = W[(size_t)(k0 + kk) * ldw + n0 + (lane & 31)]; }
    LDS_WAIT(); asm volatile("" ::: "memory");
    const int c = lane & 7;
#pragma unroll
    for (int j = 0; j < 4; ++j) { const int n = (lane >> 3) + 8 * j; const LAS float* sp = scr + (8 * c) * 33 + n;
        u32x2 o; o.x = pk4_fp8(sp[0 * 33] * scale, sp[1 * 33] * scale, sp[2 * 33] * scale, sp[3 * 33] * scale); o.y = pk4_fp8(sp[4 * 33] * scale, sp[5 * 33] * scale, sp[6 * 33] * scale, sp[7 * 33] * scale);
        *(u32x2*)(dst + (size_t)(drow0 + n) * dpitch + dk0 + k0 + 8 * c) = o; }
    LDS_WAIT(); asm volatile("" ::: "memory");
}
__device__ __forceinline__ void convert_small(Frame& F, int l, int gw, int NGW) {
    unsigned char* const ws_ = F.wsp(); float* const out_ = F.outp(); (void)ws_; (void)out_;
    LAS float* scr = (LAS float*)(F.lds + F.wave * 16384);
    bf16_t* wcat = (bf16_t*)(ws_ + WS_WSMALL + (size_t)l * WSMALL_LAYER); bf16_t* wmerge = wcat + (size_t)N1 * D; bf16_t* wo = wmerge + (size_t)D * ACTC;
    constexpr int I_IN = 16 * 128, I_GATE = 16 * 96, I_BR = 8 * 32, I_O = 16 * 32, NIT = I_IN + I_GATE + 3 * I_BR + I_O;
    for (int it = gw; it < NIT; it += NGW) {
        int r = it;
        if (r < I_IN) { transpose_item_fp8(F.in[I_WIN] + (size_t)l * D * INC, INC, 64 * (r / 128), 32 * (r % 128), (unsigned char*)wcat, D, 32 * (r % 128), 0, scr, F.lane, FP8_SW13); continue; } r -= I_IN;
        if (r < I_GATE) { transpose_item_fp8(F.in[I_WGATE] + (size_t)l * D * GC, GC, 64 * (r / 96), 32 * (r % 96), (unsigned char*)wcat + (size_t)ZC * D, D, 32 * (r % 96), 0, scr, F.lane, FP8_SW13); continue; } r -= I_GATE;
        if (r < 3 * I_BR) { const int br = r / I_BR; r %= I_BR; const float* src = F.in[I_WCONVOUT + br] + (size_t)l * 512 * D;
            transpose_item(src, D, 64 * (r / 32), 32 * (r % 32), wmerge, ACTC, 32 * (r % 32), 512 * br, scr, F.lane); continue; } r -= 3 * I_BR;
        transpose_item_fp8(F.in[I_WOUT] + (size_t)l * D * D, D, 64 * (r / 32), 32 * (r % 32), (unsigned char*)wo, D, 32 * (r % 32), 0, scr, F.lane, FP8_SW13);
    }
}
__device__ __forceinline__ void convert_moe(Frame& F, int l, int gw, int NGW) {
    unsigned char* const ws_ = F.wsp(); float* const out_ = F.outp(); (void)ws_; (void)out_;
    LAS float* scr = (LAS float*)(F.lds + F.wave * 16384);
    unsigned char* w13 = ws_ + WS_W13; unsigned char* w2t = ws_ + WS_W2;
    constexpr int I_UP = 16 * 64, I_DN = 32 * 32, PER_E = 2 * I_UP + I_DN, NIT = NE * PER_E;
    for (int it = gw; it < NIT; it += NGW) {
        const int e = it / PER_E; int r = it % PER_E;
        if (r < 2 * I_UP) { const int w3 = r / I_UP; r %= I_UP; const int n0 = 32 * (r % 64);
            const float* src = F.in[w3 ? I_W3 : I_W1] + ((size_t)l * NE + e) * D * FF;
            transpose_item_fp8(src, FF, 64 * (r / 64), n0, w13 + (size_t)e * 4096 * D, D, (n0 / 128) * 256 + (n0 % 128) + 128 * w3, 0, scr, F.lane, FP8_SW13); continue; } r -= 2 * I_UP;
        const float* src = F.in[I_W2] + ((size_t)l * NE + e) * FF * D;
        transpose_item_fp8(src, D, 64 * (r / 32), 32 * (r % 32), w2t + (size_t)e * D * FF, FF, 32 * (r % 32), 0, scr, F.lane, FP8_SW2);
    }
}
__device__ __forceinline__ void ada_item(Frame& F, int item) {
    unsigned char* const ws_ = F.wsp(); float* const out_ = F.outp(); (void)ws_; (void)out_;
    LAS float* sc = (LAS float*)F.lds;
    const int l = item / 96, cb = item % 96;
    { const float* cin = F.in[I_C]; for (int i = F.tid; i < 32 * 1024; i += 512) { const float c = cin[i]; sc[i] = c / (1.f + expf(-c)); } }
    __syncthreads();
    float acc[32];
#pragma unroll
    for (int b = 0; b < 32; ++b) acc[b] = 0.f;
    const float* W = F.in[I_WADA] + (size_t)l * D * 6144 + cb * 64 + F.lane;
    const int k0 = F.wave * 128;
    for (int k = k0; k < k0 + 128; k += 4) {
        float w[4];
#pragma unroll
        for (int q = 0; q < 4; ++q) w[q] = W[(size_t)(k + q) * 6144];
#pragma unroll
        for (int b = 0; b < 32; ++b) { const f32x4 s = *(const LAS f32x4*)(sc + b * 1024 + k); acc[b] += s[0] * w[0] + s[1] * w[1] + s[2] * w[2] + s[3] * w[3]; }
    }
    __syncthreads();
    LAS float* red = (LAS float*)F.lds;
#pragma unroll
    for (int b = 0; b < 32; ++b) red[(F.wave * 32 + b) * 64 + F.lane] = acc[b];
    __syncthreads();
    float* ada = (float*)(ws_ + WS_ADA) + (size_t)l * 32 * 6144; const float* bada = F.in[I_BADA];
    for (int o = F.tid; o < 2048; o += 512) { const int b = o >> 6, j = o & 63; float s = 0.f;
#pragma unroll
        for (int w = 0; w < 8; ++w) s += red[(w * 32 + b) * 64 + j];
        ada[(size_t)b * 6144 + cb * 64 + j] = s + bada[l * 6144 + cb * 64 + j]; }
    __syncthreads();
}

__device__ __forceinline__ void ra_math(f32x4 (&v)[4][4], const int rl0, const int row0, const int lane_, const float* ada_l, unsigned char* UF8, float* flog, const float* bfg_l, const LAS float* wff) {
    constexpr int RB = 4;
    const int b = row0 >> 11;
    const int ln_ = opaque_v(lane_);
    float sm[RB];
#pragma unroll
    for (int r = 0; r < RB; ++r) { sm[r] = 0.f;
#pragma unroll
        for (int j = 0; j < 4; ++j) sm[r] += (v[r][j].x + v[r][j].y) + (v[r][j].z + v[r][j].w); }
    wave_sum_n<RB>(sm);
    float sq[RB];
#pragma unroll
    for (int r = 0; r < RB; ++r) { const float mean = sm[r] * (1.f / D); sq[r] = 0.f;
#pragma unroll
        for (int j = 0; j < 4; ++j) { v[r][j] = v[r][j] - mean; sq[r] += (v[r][j].x * v[r][j].x + v[r][j].y * v[r][j].y) + (v[r][j].z * v[r][j].z + v[r][j].w * v[r][j].w); } }
    wave_sum_n<RB>(sq);
    float fl[RB * 8];
#pragma unroll
    for (int i = 0; i < RB * 8; ++i) fl[i] = 0.f;
    float rstd[RB];
#pragma unroll
    for (int r = 0; r < RB; ++r) rstd[r] = 1.f / sqrtf(sq[r] * (1.f / D) + LN_EPS);
#pragma unroll
    for (int j = 0; j < 4; ++j) { const f32x4 a = *((const f32x4*)(ada_l + (size_t)b * 6144) + ln_ + 64 * j), c = *((const f32x4*)(ada_l + (size_t)b * 6144 + D) + ln_ + 64 * j) + 1.f;
        f32x4 u[RB];
#pragma unroll
        for (int r = 0; r < RB; ++r) { u[r] = v[r][j] * rstd[r] * c + a;
            *((unsigned*)(UF8 + (size_t)(rl0 + r) * D) + ln_ + 64 * j) = pk4_fp8(u[r].x * FP8_SX, u[r].y * FP8_SX, u[r].z * FP8_SX, u[r].w * FP8_SX); }
#pragma unroll
        for (int h = 0; h < 8; ++h) { const f32x4 w = *(const LAS f32x4*)(wff + h * 1024 + 256 * j + 4 * ln_);
#pragma unroll
            for (int r = 0; r < RB; ++r) fl[r * 8 + h] += (u[r].x * w.x + u[r].y * w.y) + (u[r].z * w.z + u[r].w * w.w); } }
#pragma unroll
    for (int hf = 0; hf < 2; ++hf) { const float (&vv)[16] = *reinterpret_cast<const float (*)[16]>(&fl[hf * 16]);
        const int idx = (ln_ >> 2) & 15; const float xv = rs16(vv, ln_) + bfg_l[idx & 7];
        const float ls = fminf(xv, 0.f) - log1pf(expf(-fabsf(xv)));
        if ((ln_ & 3) == 0) flog[(size_t)(row0 + 2 * hf + (idx >> 3)) * 8 + (idx & 7)] = ls; }
}
__device__ __forceinline__ void stage_wff(Frame& F, int l) {
    LAS float* wff = (LAS float*)F.lds;
    const float* win = F.in[I_WIN] + (size_t)l * D * INC;
#pragma unroll 8
    for (int i = F.tid; i < 8192; i += 512) { const int k = i >> 3, h = i & 7; wff[h * 1024 + k] = win[(size_t)k * INC + ZC + h]; }
    __syncthreads();
}
__device__ __forceinline__ void phase_ra(Frame& F, int l, int hb, const bool stage) {
    unsigned char* const ws_ = F.wsp(); float* const out_ = F.outp();
    if (stage) stage_wff(F, l);
    const LAS float* wff = (const LAS float*)F.lds;
    const float* xsrc = (l == 0) ? F.in[I_X] : out_;
    const float* ada = (const float*)(ws_ + WS_ADA) + (size_t)l * 32 * 6144;
    unsigned char* UF8 = ws_ + (hb ? WS_UF8_H1 : WS_HOUT); float* flog = (float*)(ws_ + WS_FLOG); const float* bfg = F.in[I_BFORGET] + l * 8;
    const int gw = F.bid * NWAVES + F.wave, NGW = F.G * NWAVES;
    constexpr int RB = 4;
    for (int rl0 = gw * RB; rl0 < TH; rl0 += NGW * RB) {
        const int row0 = hb * TH + rl0;
        f32x4 v[RB][4];
#pragma unroll
        for (int r = 0; r < RB; ++r) { const f32x4* xr = (const f32x4*)(xsrc + (size_t)(row0 + r) * D) + F.lane;
#pragma unroll
            for (int j = 0; j < 4; ++j) v[r][j] = xr[64 * j]; }
        ra_math(v, rl0, row0, F.lane, ada, UF8, flog, bfg, wff);
    }
    __syncthreads();
}

constexpr int CV_HS = 0, CV_CO = 96256;
__device__ __forceinline__ void conv_unit(Frame& F, int l, int unit) {
    unsigned char* const ws_ = F.wsp();
    const int tid = opaque_v(F.tid), lane = tid & 63, wave = __builtin_amdgcn_readfirstlane(tid >> 6);
    const int bl = unit >> 5, t0 = (unit & 31) * 64;
    const bf16_t* Z = (const bf16_t*)(ws_ + WS_Z); bf16_t* ACT = (bf16_t*)(ws_ + WS_ACT);
    LAS unsigned char* L = F.lds;
#pragma unroll
    for (int hb2 = 0; hb2 < 2; ++hb2) {
        u32x4 av[6], gv[6];
#pragma unroll
        for (int q = 0; q < 6; ++q) { const int item = tid + 512 * (6 * hb2 + q), i = item >> 6, cg = item & 63, t = t0 - 30 + i;
            av[q] = (u32x4){0u, 0u, 0u, 0u}; gv[q] = (u32x4){0u, 0u, 0u, 0u};
            if (item < 94 * 64 && t >= 0) { const bf16_t* zr = Z + (size_t)(bl * SEQ + t) * ZP + cg * 8; av[q] = *(const u32x4*)(zr + C_AVAL); gv[q] = *(const u32x4*)(zr + C_AGATE); } }
#pragma unroll
        for (int q = 0; q < 6; ++q) { const int item = tid + 512 * (6 * hb2 + q), i = item >> 6, cg = item & 63;
            if (item < 94 * 64) { u32x4 o;
#pragma unroll
                for (int k = 0; k < 4; ++k) o[k] = pk2(bflo(av[q][k]) * sigm(bflo(gv[q][k])), bfhi(av[q][k]) * sigm(bfhi(gv[q][k])));
                *(LAS u32x4*)(L + CV_HS + (i * 512 + cg * 8) * 2) = o; } }
    }
    const float* convw = F.in[I_CONVW] + (size_t)l * 31 * 512; const float* clng = F.in[I_CLNG] + l * 512; const float* clnb = F.in[I_CLNB] + l * 512;
    float w[31];
#pragma unroll
    for (int j = 0; j < 31; ++j) w[j] = convw[j * 512 + tid];
    const float cb = F.in[I_CONVB][l * 512 + tid];
    const int ti = wave * 2 + (lane >> 5), seg = lane & 31;
    f32x4 lg[4], lb[4];
#pragma unroll
    for (int i = 0; i < 4; ++i) { lg[i] = *(const f32x4*)(clng + i * 128 + seg * 4); lb[i] = *(const f32x4*)(clnb + i * 128 + seg * 4); }
    __syncthreads();
    for (int sb = 0; sb < 4; ++sb) {
        float hr[46];
#pragma unroll
        for (int i = 0; i < 46; ++i) hr[i] = __uint_as_float((unsigned)(*(const LAS bf16_t*)(L + CV_HS + ((sb * 16 + i) * 512 + tid) * 2)) << 16);
#pragma unroll
        for (int i = 0; i < 16; ++i) { float o = cb;
#pragma unroll
            for (int j = 0; j < 31; ++j) o += w[j] * hr[i + j];
            *(LAS float*)(L + CV_CO + (i * 512 + tid) * 4) = o; }
        __syncthreads();
        { f32x4 v[4]; float s = 0.f;
#pragma unroll
          for (int i = 0; i < 4; ++i) { v[i] = *(const LAS f32x4*)(L + CV_CO + (ti * 512 + i * 128 + seg * 4) * 4); s += (v[i].x + v[i].y) + (v[i].z + v[i].w); }
          s += swz_xor1(s); s += swz_xor2(s); s += swz_xor4(s); s += swz_xor8(s); s += swz_xor16(s);
          const float mean = s * (1.f / 512.f); float s2 = 0.f;
#pragma unroll
          for (int i = 0; i < 4; ++i) { v[i] = v[i] - mean; s2 += (v[i].x * v[i].x + v[i].y * v[i].y) + (v[i].z * v[i].z + v[i].w * v[i].w); }
          s2 += swz_xor1(s2); s2 += swz_xor2(s2); s2 += swz_xor4(s2); s2 += swz_xor8(s2); s2 += swz_xor16(s2);
          const float rstd = 1.f / sqrtf(s2 * (1.f / 512.f) + LN_EPS);
          bf16_t* orow = ACT + (size_t)(bl * SEQ + t0 + sb * 16 + ti) * ACTC;
#pragma unroll
          for (int i = 0; i < 4; ++i) { const f32x4 y = v[i] * rstd * lg[i] + lb[i];
              *(u32x2*)(orow + i * 128 + seg * 4) = (u32x2){pk2(y.x * sigm(y.x), y.y * sigm(y.y)), pk2(y.z * sigm(y.z), y.w * sigm(y.w))}; } }
        __syncthreads();
    }
}

constexpr int RP = 72;
constexpr int R_QS = 0, R_QD = 9216, R_KS = 18432, R_VT = 27648, R_PS = 46080, R_OS = 55296, R_OSP = 132;
constexpr int RA_KT = 0, RA_VT = 9216;
__device__ __forceinline__ bf16x8 ldfrag(const LAS unsigned char* base, int row, int col) { return *(const LAS bf16x8*)(base + (row * RP + col) * 2); }
__device__ __forceinline__ float ret_lg2(int h) { return log1pf(-exp2f(-5.f - (float)h)) * 1.4426950408889634f; }
struct RaIn { u32x2 k1, k2; f32x4 cs, sn; u32x4 va, vb; };
__device__ __forceinline__ void ret_a_load(Frame& F, int item, int tid, RaIn& in) {
    unsigned char* const ws_ = F.wsp();
    const int n = item & 31, h = (item >> 5) & 3, bl = item >> 7;
    const bf16_t* Z = (const bf16_t*)(ws_ + WS_Z); const float* rotc = (const float*)(ws_ + WS_ROT); const float* rots = rotc + 2048 * 32;
    const int srow = tid >> 3, j4 = tid & 7, t = n * 64 + srow; const bf16_t* zr = Z + (size_t)(bl * SEQ + t) * ZP;
    in.k1 = *(const u32x2*)(zr + C_RK + h * 64 + 4 * j4); in.k2 = *(const u32x2*)(zr + C_RK + h * 64 + 32 + 4 * j4);
    in.cs = *(const f32x4*)(rotc + t * 32 + 4 * j4); in.sn = *(const f32x4*)(rots + t * 32 + 4 * j4);
    in.va = *(const u32x4*)(zr + C_RV + h * 128 + j4 * 16); in.vb = *(const u32x4*)(zr + C_RV + h * 128 + j4 * 16 + 8);
}
__device__ __forceinline__ void ret_a_compute(Frame& F, int item, int tid, const RaIn& in) {
    unsigned char* const ws_ = F.wsp();
    const int h = (item >> 5) & 3;
    const int lane = tid & 63, w = __builtin_amdgcn_readfirstlane(tid >> 6), fr = lane & 15, fq = lane >> 4;
    LAS unsigned char* L = F.lds;
    bf16_t* KV = (bf16_t*)(ws_ + WS_HOUT) + (size_t)item * 8192;
    const float lg2 = ret_lg2(h);
    const int srow = tid >> 3, j4 = tid & 7;
    { const u32x2 k1 = in.k1, k2 = in.k2; const f32x4 cs = in.cs, sn = in.sn; const u32x4 va = in.va, vb = in.vb;
      const float dk = 0.125f * __builtin_amdgcn_exp2f(lg2 * (float)(63 - srow));
      const float y1[4] = {bflo(k1.x), bfhi(k1.x), bflo(k1.y), bfhi(k1.y)}, y2[4] = {bflo(k2.x), bfhi(k2.x), bflo(k2.y), bfhi(k2.y)};
#pragma unroll
      for (int i = 0; i < 4; ++i) { const float ka = y1[i] * cs[i] - y2[i] * sn[i], kb = y1[i] * sn[i] + y2[i] * cs[i];
        *(LAS bf16_t*)(L + RA_KT + ((4 * j4 + i) * RP + srow) * 2) = (bf16_t)f2bf(ka * dk); *(LAS bf16_t*)(L + RA_KT + ((32 + 4 * j4 + i) * RP + srow) * 2) = (bf16_t)f2bf(kb * dk); }
#pragma unroll
      for (int i = 0; i < 4; ++i) { const unsigned a = va[i], b = vb[i];
        *(LAS bf16_t*)(L + RA_VT + ((j4 * 16 + 2 * i) * RP + srow) * 2) = (bf16_t)(a & 0xffffu); *(LAS bf16_t*)(L + RA_VT + ((j4 * 16 + 2 * i + 1) * RP + srow) * 2) = (bf16_t)(a >> 16);
        *(LAS bf16_t*)(L + RA_VT + ((j4 * 16 + 8 + 2 * i) * RP + srow) * 2) = (bf16_t)(b & 0xffffu); *(LAS bf16_t*)(L + RA_VT + ((j4 * 16 + 8 + 2 * i + 1) * RP + srow) * 2) = (bf16_t)(b >> 16); } }
    LDS_BARRIER();
    { const int dt = w & 3, et0 = (w >> 2) * 4;
      const bf16x8 kt0 = ldfrag(L + RA_KT, dt * 16 + fr, fq * 8), kt1 = ldfrag(L + RA_KT, dt * 16 + fr, 32 + fq * 8);
#pragma unroll
      for (int q = 0; q < 4; ++q) { const int et = et0 + q;
        const bf16x8 v0 = ldfrag(L + RA_VT, et * 16 + fr, fq * 8), v1 = ldfrag(L + RA_VT, et * 16 + fr, 32 + fq * 8);
        f32x4 sacc = (f32x4){0.f, 0.f, 0.f, 0.f};
        sacc = __builtin_amdgcn_mfma_f32_16x16x32_bf16(kt0, v0, sacc, 0, 0, 0); sacc = __builtin_amdgcn_mfma_f32_16x16x32_bf16(kt1, v1, sacc, 0, 0, 0);
        *(u32x2*)(KV + (et * 16 + fr) * 64 + dt * 16 + 4 * fq) = (u32x2){pk2(sacc[0], sacc[1]), pk2(sacc[2], sacc[3])}; } }
    LDS_BARRIER();
}
__device__ __forceinline__ void ret_a_run(Frame& F, int nitems) {
    const int tid = opaque_v(F.tid);
    RaIn cur, nxt; int it = F.bid;
    if (it < nitems) ret_a_load(F, it, tid, cur);
    for (; it < nitems; it += F.G) {
        const int itn = it + F.G;
        if (itn < nitems) ret_a_load(F, itn, tid, nxt);
        ret_a_compute(F, it, tid, cur);
        cur = nxt;
    }
}
__device__ __forceinline__ void ret_scan_item(Frame& F, int c) {
    unsigned char* const ws_ = F.wsp();
    const int bh = c >> 2, idx = (c & 3) * 512 + F.tid;
    const float cdec = __builtin_amdgcn_exp2f(ret_lg2(bh & 3) * 64.f);
    const f32x4* KV = (const f32x4*)(ws_ + WS_HOUT) + (size_t)bh * 32 * 2048 + idx; u32x2* Sg = (u32x2*)(ws_ + WS_U) + (size_t)bh * 32 * 2048 + idx;
    float z0 = 0.f; asm volatile("" : "+v"(z0));
    f32x4 st = (f32x4){z0, z0, z0, z0};
#pragma unroll
    for (int hf = 0; hf < 2; ++hf) {
        f32x4 kv[16];
#pragma unroll
        for (int n = 0; n < 16; ++n) kv[n] = KV[(size_t)(hf * 16 + n) * 2048];
#pragma unroll
        for (int n = 0; n < 16; ++n) { Sg[(size_t)(hf * 16 + n) * 2048] = (u32x2){pk2(st[0], st[1]), pk2(st[2], st[3])}; st = st * cdec + kv[n]; }
    }
}
struct RcIn { u32x2 q1, q2, k1, k2; f32x4 cs, sn; u32x4 va, vb, ga, gb; u32x2 kv[4]; };
constexpr int R_STL = 89088;
__device__ __forceinline__ void ret_c_load(Frame& F, int item, int tid, RcIn& in) {
    unsigned char* const ws_ = F.wsp();
    const int n = item & 31, h = (item >> 5) & 3, bl = item >> 7;
    const int lane = tid & 63, w = __builtin_amdgcn_readfirstlane(tid >> 6), fr = lane & 15, fq = lane >> 4;
    const bf16_t* Z = (const bf16_t*)(ws_ + WS_Z); const float* rotc = (const float*)(ws_ + WS_ROT); const float* rots = rotc + 2048 * 32;
    { const u32x2* KVg = (const u32x2*)(ws_ + WS_HOUT) + (size_t)item * 2048 + tid;
#pragma unroll
      for (int q = 0; q < 4; ++q) in.kv[q] = KVg[512 * q]; }
    (void)fr; (void)fq;
    const int srow = tid >> 3, j4 = tid & 7, t = n * 64 + srow; const bf16_t* zr = Z + (size_t)(bl * SEQ + t) * ZP;
    in.q1 = *(const u32x2*)(zr + C_RQ + h * 64 + 4 * j4); in.q2 = *(const u32x2*)(zr + C_RQ + h * 64 + 32 + 4 * j4);
    in.k1 = *(const u32x2*)(zr + C_RK + h * 64 + 4 * j4); in.k2 = *(const u32x2*)(zr + C_RK + h * 64 + 32 + 4 * j4);
    in.cs = *(const f32x4*)(rotc + t * 32 + 4 * j4); in.sn = *(const f32x4*)(rots + t * 32 + 4 * j4);
    in.va = *(const u32x4*)(zr + C_RV + h * 128 + j4 * 16); in.vb = *(const u32x4*)(zr + C_RV + h * 128 + j4 * 16 + 8);
    { const int j = w * 8 + (lane >> 3), cs16 = (lane & 7) * 16; const size_t grow = (size_t)(bl * SEQ + n * 64 + j);
      in.ga = *(const u32x4*)(Z + grow * ZP + C_RG + h * 128 + cs16); in.gb = *(const u32x4*)(Z + grow * ZP + C_RG + h * 128 + cs16 + 8); }
}
__device__ __forceinline__ void ret_c_compute(Frame& F, int item, int tid, const RcIn& in, f32x4 (&st)[4]) {
    unsigned char* const ws_ = F.wsp();
    const int n = item & 31, h = (item >> 5) & 3, bl = item >> 7;
    const int lane = tid & 63, w = __builtin_amdgcn_readfirstlane(tid >> 6), fr = lane & 15, fq = lane >> 4;
    LAS unsigned char* L = F.lds;
    bf16_t* ACT = (bf16_t*)(ws_ + WS_ACT);
    const float lg2 = ret_lg2(h);
    const int srow = tid >> 3, j4 = tid & 7;
    const int jt = w & 3, et0 = (w >> 2) * 4;
    { const u32x2 q1 = in.q1, q2 = in.q2, k1 = in.k1, k2 = in.k2; const f32x4 cs = in.cs, sn = in.sn; const u32x4 va = in.va, vb = in.vb;
      const float dq = __builtin_amdgcn_exp2f(lg2 * (float)(srow + 1));
      float qa[4], qb[4], ka[4], kb[4];
      { const float x1[4] = {bflo(q1.x), bfhi(q1.x), bflo(q1.y), bfhi(q1.y)}, x2[4] = {bflo(q2.x), bfhi(q2.x), bflo(q2.y), bfhi(q2.y)};
        const float y1[4] = {bflo(k1.x), bfhi(k1.x), bflo(k1.y), bfhi(k1.y)}, y2[4] = {bflo(k2.x), bfhi(k2.x), bflo(k2.y), bfhi(k2.y)};
#pragma unroll
        for (int i = 0; i < 4; ++i) { qa[i] = x1[i] * cs[i] - x2[i] * sn[i]; qb[i] = x1[i] * sn[i] + x2[i] * cs[i]; ka[i] = (y1[i] * cs[i] - y2[i] * sn[i]) * 0.125f; kb[i] = (y1[i] * sn[i] + y2[i] * cs[i]) * 0.125f; } }
      *(LAS u32x2*)(L + R_QS + (srow * RP + 4 * j4) * 2) = (u32x2){pk2(qa[0], qa[1]), pk2(qa[2], qa[3])};
      *(LAS u32x2*)(L + R_QS + (srow * RP + 32 + 4 * j4) * 2) = (u32x2){pk2(qb[0], qb[1]), pk2(qb[2], qb[3])};
      *(LAS u32x2*)(L + R_QD + (srow * RP + 4 * j4) * 2) = (u32x2){pk2(qa[0] * dq, qa[1] * dq), pk2(qa[2] * dq, qa[3] * dq)};
      *(LAS u32x2*)(L + R_QD + (srow * RP + 32 + 4 * j4) * 2) = (u32x2){pk2(qb[0] * dq, qb[1] * dq), pk2(qb[2] * dq, qb[3] * dq)};
      *(LAS u32x2*)(L + R_KS + (srow * RP + 4 * j4) * 2) = (u32x2){pk2(ka[0], ka[1]), pk2(ka[2], ka[3])};
      *(LAS u32x2*)(L + R_KS + (srow * RP + 32 + 4 * j4) * 2) = (u32x2){pk2(kb[0], kb[1]), pk2(kb[2], kb[3])};
#pragma unroll
      for (int i = 0; i < 4; ++i) { const unsigned a = va[i], b = vb[i];
        *(LAS bf16_t*)(L + R_VT + ((j4 * 16 + 2 * i) * RP + srow) * 2) = (bf16_t)(a & 0xffffu); *(LAS bf16_t*)(L + R_VT + ((j4 * 16 + 2 * i + 1) * RP + srow) * 2) = (bf16_t)(a >> 16);
        *(LAS bf16_t*)(L + R_VT + ((j4 * 16 + 8 + 2 * i) * RP + srow) * 2) = (bf16_t)(b & 0xffffu); *(LAS bf16_t*)(L + R_VT + ((j4 * 16 + 8 + 2 * i + 1) * RP + srow) * 2) = (bf16_t)(b >> 16); } }
#pragma unroll
    for (int q = 0; q < 4; ++q) { const int idx = tid + 512 * q, e = idx >> 4, d4 = idx & 15;
        *(LAS u32x2*)(L + R_STL + (e * RP + 4 * d4) * 2) = (u32x2){pk2(st[q].x, st[q].y), pk2(st[q].z, st[q].w)}; }
    LDS_BARRIER();
#pragma unroll
    for (int tt = 0; tt < 2; ++tt) { const int tl = 2 * w + tt, ti = tl >> 2, tj = tl & 3; f32x4 a = (f32x4){0.f, 0.f, 0.f, 0.f};
#pragma unroll
        for (int ks = 0; ks < 2; ++ks) a = __builtin_amdgcn_mfma_f32_16x16x32_bf16(ldfrag(L + R_KS, tj * 16 + fr, ks * 32 + fq * 8), ldfrag(L + R_QS, ti * 16 + fr, ks * 32 + fq * 8), a, 0, 0, 0);
        const int jj = ti * 16 + fr, l0 = tj * 16 + 4 * fq; float p[4];
#pragma unroll
        for (int i = 0; i < 4; ++i) { const int dlt = jj - (l0 + i); p[i] = a[i] * __builtin_amdgcn_exp2f(lg2 * (float)(dlt < 0 ? -dlt : dlt)); }
        *(LAS u32x2*)(L + R_PS + (jj * RP + l0) * 2) = (u32x2){pk2(p[0], p[1]), pk2(p[2], p[3])}; }
    LDS_BARRIER();
    { const bf16x8 pf0 = ldfrag(L + R_PS, jt * 16 + fr, fq * 8), pf1 = ldfrag(L + R_PS, jt * 16 + fr, 32 + fq * 8);
      const bf16x8 qd0 = ldfrag(L + R_QD, jt * 16 + fr, fq * 8), qd1 = ldfrag(L + R_QD, jt * 16 + fr, 32 + fq * 8);
#pragma unroll
      for (int q = 0; q < 4; ++q) { const int et = et0 + q;
        const bf16x8 v0 = ldfrag(L + R_VT, et * 16 + fr, fq * 8), v1 = ldfrag(L + R_VT, et * 16 + fr, 32 + fq * 8);
        f32x4 a = (f32x4){0.f, 0.f, 0.f, 0.f};
        a = __builtin_amdgcn_mfma_f32_16x16x32_bf16(v0, pf0, a, 0, 0, 0); a = __builtin_amdgcn_mfma_f32_16x16x32_bf16(v1, pf1, a, 0, 0, 0);
        a = __builtin_amdgcn_mfma_f32_16x16x32_bf16(ldfrag(L + R_STL, et * 16 + fr, fq * 8), qd0, a, 0, 0, 0); a = __builtin_amdgcn_mfma_f32_16x16x32_bf16(ldfrag(L + R_STL, et * 16 + fr, 32 + fq * 8), qd1, a, 0, 0, 0);
        *(LAS f32x4*)(L + R_OS + ((jt * 16 + fr) * R_OSP + et * 16 + 4 * fq) * 4) = a; } }
    LDS_BARRIER();
    { const int j = w * 8 + (lane >> 3), cs16 = (lane & 7) * 16;
      f32x4 o[4]; float s = 0.f;
#pragma unroll
      for (int i = 0; i < 4; ++i) { o[i] = *(const LAS f32x4*)(L + R_OS + (j * R_OSP + cs16 + 4 * i) * 4); s += (o[i].x + o[i].y) + (o[i].z + o[i].w); }
      s += swz_xor1(s); s += swz_xor2(s); s += swz_xor4(s);
      const float mean = s * (1.f / 128.f); float s2 = 0.f;
#pragma unroll
      for (int i = 0; i < 4; ++i) { o[i] = o[i] - mean; s2 += (o[i].x * o[i].x + o[i].y * o[i].y) + (o[i].z * o[i].z + o[i].w * o[i].w); }
      s2 += swz_xor1(s2); s2 += swz_xor2(s2); s2 += swz_xor4(s2);
      const float rstd = 1.f / sqrtf(s2 * (1.f / 128.f) + LN_EPS);
      const size_t grow = (size_t)(bl * SEQ + n * 64 + j);
      const u32x4 ga = in.ga, gb = in.gb;
      u32x4 oa, ob;
#pragma unroll
      for (int i = 0; i < 4; ++i) { const unsigned g = (i < 2) ? ga[2 * i] : gb[2 * (i - 2)], g2 = (i < 2) ? ga[2 * i + 1] : gb[2 * (i - 2) + 1];
        const float g0 = bflo(g), g1 = bfhi(g), g2a = bflo(g2), g3 = bfhi(g2);
        const unsigned p0 = pk2(g0 * sigm(g0) * o[i].x * rstd, g1 * sigm(g1) * o[i].y * rstd), p1 = pk2(g2a * sigm(g2a) * o[i].z * rstd, g3 * sigm(g3) * o[i].w * rstd);
        if (i < 2) { oa[2 * i] = p0; oa[2 * i + 1] = p1; } else { ob[2 * (i - 2)] = p0; ob[2 * (i - 2) + 1] = p1; } }
      *(u32x4*)(ACT + grow * ACTC + 512 + h * 128 + cs16) = oa; *(u32x4*)(ACT + grow * ACTC + 512 + h * 128 + cs16 + 8) = ob; }
    LDS_BARRIER();
    { const float cdec = __builtin_amdgcn_exp2f(lg2 * 64.f);
#pragma unroll
      for (int q = 0; q < 4; ++q) st[q] = st[q] * cdec + bf4_to_f32(in.kv[q]); }
}
__device__ __forceinline__ void ret_c_run(Frame& F) {
    unsigned char* const ws_ = F.wsp();
    const int tid = opaque_v(F.tid);
    const int bh = F.bid >> 2, n0 = (F.bid & 3) * 8;
    const float cdec = __builtin_amdgcn_exp2f(ret_lg2(bh & 3) * 64.f);
    f32x4 st[4];
#pragma unroll
    for (int q = 0; q < 4; ++q) st[q] = (f32x4){0.f, 0.f, 0.f, 0.f};
    { const u32x2* KVg = (const u32x2*)(ws_ + WS_HOUT) + (size_t)(bh * 32) * 2048 + tid;
      for (int m0 = 0; m0 < n0; m0 += 4) { u32x2 kv[4][4];
#pragma unroll
          for (int m = 0; m < 4; ++m)
#pragma unroll
              for (int q = 0; q < 4; ++q) kv[m][q] = KVg[(size_t)(m0 + m) * 2048 + 512 * q];
#pragma unroll
          for (int m = 0; m < 4; ++m)
#pragma unroll
              for (int q = 0; q < 4; ++q) st[q] = st[q] * cdec + bf4_to_f32(kv[m][q]); } }
    RcIn cur, nxt; const int it0 = bh * 32 + n0;
    ret_c_load(F, it0, tid, cur);
    for (int j = 0; j < 8; ++j) {
        if (j + 1 < 8) ret_c_load(F, it0 + j + 1, tid, nxt);
        ret_c_compute(F, it0 + j, tid, cur, st);
        cur = nxt;
    }
}

namespace attn_body {
using bf16=__hip_bfloat16;
using bf16x8=__attribute__((ext_vector_type(8)))short;
using s16x4=__attribute__((ext_vector_type(4)))short;
using f32x16=__attribute__((ext_vector_type(16)))float;
using u32x4=__attribute__((ext_vector_type(4)))unsigned;
constexpr int SEQ=2048,D=64,DM=4160,OPITCH=1536;
constexpr int NW=8,QBLK=32,QB=QBLK*NW,KVBLK=64,NQB=SEQ/QB;
__device__ __forceinline__ int crow(int r,int hi){return (r&3)+8*(r>>2)+4*hi;}
#define SBAR() __builtin_amdgcn_sched_barrier(0)
__device__ __forceinline__ void cmask(f32x16&p0,f32x16&p1,int jb,int qrel,int hi){
  const float NEG=-INFINITY; int kb=64*jb+4*hi;
  #pragma unroll
  for(int r=0;r<16;++r){int kv=kb+(r&3)+8*(r>>2); if(kv>qrel)p0[r]=NEG; if(kv+32>qrel)p1[r]=NEG;}
}

constexpr int NSLOT=3, SLOTB=8192;
constexpr int LDS_K=0, LDS_V=NSLOT*SLOTB, LDS_WS=2*NSLOT*SLOTB, LDS_OST=LDS_WS+NW*64*4, LDS_CUM=LDS_OST+NW*4096, LDS_BYTES=LDS_CUM+SEQ*4;
constexpr float C2=0.125f*1.4426950408889634f;
__device__ __forceinline__ void glds16(const void*gsrc,unsigned lds_dst){unsigned keep;
  asm volatile("s_mov_b32 %0, m0\n\ts_mov_b32 m0, %2\n\ts_nop 0\n\tglobal_load_lds_dwordx4 %1, off\n\ts_mov_b32 m0, %0":"=&s"(keep):"v"(gsrc),"s"(lds_dst):"memory");}
__device__ __forceinline__ float max3f(float a,float b,float c){float r;asm("v_max3_f32 %0, %1, %2, %3":"=v"(r):"v"(a),"v"(b),"v"(c));return r;}
__device__ __forceinline__ float max2f(float a,float b){float r;asm("v_max_f32_e32 %0, %1, %2":"=v"(r):"v"(a),"v"(b));return r;}
__device__ __forceinline__ float fadd_s(float a,float b){float r;asm("v_add_f32_e32 %0, %1, %2":"=v"(r):"v"(a),"v"(b));return r;}
__device__ __forceinline__ float fsub_s(float a,float b){float r;asm("v_sub_f32_e32 %0, %1, %2":"=v"(r):"v"(a),"v"(b));return r;}
typedef float f32x2_t __attribute__((ext_vector_type(2))); typedef __bf16 bf16x2_t __attribute__((ext_vector_type(2)));
__device__ __forceinline__ unsigned cvtpk_s(float lo,float hi){f32x2_t v={lo,hi};bf16x2_t b=__builtin_convertvector(v,bf16x2_t);return __builtin_bit_cast(unsigned,b);}
#define WAIT_BAR(N) asm volatile("s_waitcnt vmcnt(" #N ") lgkmcnt(0)\n\ts_barrier":::"memory")

__device__ __forceinline__ void qkt(f32x16&p0,f32x16&p1,const char*Kslot,const bf16x8*qr,int r32,int hi){
  const char*kb=Kslot+hi*1024+r32*16;
  #pragma unroll
  for(int d0=0;d0<4;++d0){
    const bf16x8 b0=*reinterpret_cast<const bf16x8*>(kb+d0*2048);
    const bf16x8 b1=*reinterpret_cast<const bf16x8*>(kb+d0*2048+512);
    if(d0==0){p0=__builtin_amdgcn_mfma_f32_32x32x16_bf16(b0,qr[0],p0,0,0,0);p1=__builtin_amdgcn_mfma_f32_32x32x16_bf16(b1,qr[0],p1,0,0,0);}
    else{p0=__builtin_amdgcn_mfma_f32_32x32x16_bf16(b0,qr[d0],p0,0,0,0);p1=__builtin_amdgcn_mfma_f32_32x32x16_bf16(b1,qr[d0],p1,0,0,0);}}
}
typedef __attribute__((address_space(3))) const char* lds_cptr;
typedef short v4i16_t __attribute__((ext_vector_type(4)));
__device__ __forceinline__ void kload8(bf16x8*kf,lds_cptr kp){
  kf[0]=*(const __attribute__((address_space(3))) bf16x8*)(kp);      kf[1]=*(const __attribute__((address_space(3))) bf16x8*)(kp+512);
  kf[2]=*(const __attribute__((address_space(3))) bf16x8*)(kp+2048); kf[3]=*(const __attribute__((address_space(3))) bf16x8*)(kp+2560);
  kf[4]=*(const __attribute__((address_space(3))) bf16x8*)(kp+4096); kf[5]=*(const __attribute__((address_space(3))) bf16x8*)(kp+4608);
  kf[6]=*(const __attribute__((address_space(3))) bf16x8*)(kp+6144); kf[7]=*(const __attribute__((address_space(3))) bf16x8*)(kp+6656);
}
__device__ __forceinline__ void kload2(bf16x8*kf,lds_cptr kp,int j){ kf[2*j]=*(const __attribute__((address_space(3))) bf16x8*)(kp+j*2048); kf[2*j+1]=*(const __attribute__((address_space(3))) bf16x8*)(kp+j*2048+512); }
__device__ __forceinline__ s16x4 vtr(lds_cptr p){ return __builtin_bit_cast(s16x4,__builtin_amdgcn_ds_read_tr16_b64_v4i16((__attribute__((address_space(3))) v4i16_t*)p)); }
__device__ __forceinline__ float rowmax(const f32x16&p0,const f32x16&p1){
  float a=max3f(p0[0],p0[1],p1[0]),b=max3f(p0[2],p0[3],p1[1]);a=max3f(a,p1[2],p1[3]);
  #pragma unroll
  for(int r=4;r<16;r+=4){a=max3f(a,p0[r],p0[r+1]);b=max3f(b,p0[r+2],p0[r+3]);a=max3f(a,p1[r],p1[r+1]);b=max3f(b,p1[r+2],p1[r+3]);}
  const float m=max2f(a,b);
  auto rr=__builtin_amdgcn_permlane32_swap(__float_as_uint(m),__float_as_uint(m),false,false);
  return max2f(__uint_as_float(rr[0]),__uint_as_float(rr[1]));
}
__device__ __forceinline__ void pv(f32x16*o,int vb,bf16x8 pa0,bf16x8 pa1,bf16x8 pa2,bf16x8 pa3){
  #pragma unroll
  for(int d0=0;d0<2;++d0){s16x4 lo[4],hi[4];
    #pragma unroll
    for(int ks=0;ks<4;++ks){
      asm volatile("ds_read_b64_tr_b16 %0,%1 offset:%c2":"=&v"(lo[ks]):"v"(vb),"i"(d0*4096+ks*1024):"memory");
      asm volatile("ds_read_b64_tr_b16 %0,%1 offset:%c2":"=&v"(hi[ks]):"v"(vb),"i"(d0*4096+ks*1024+512):"memory");}
    asm volatile("s_waitcnt lgkmcnt(0)":::"memory");SBAR();
    #define PK(k) (bf16x8){lo[k][0],lo[k][1],lo[k][2],lo[k][3],hi[k][0],hi[k][1],hi[k][2],hi[k][3]}
    o[d0]=__builtin_amdgcn_mfma_f32_32x32x16_bf16(pa0,PK(0),o[d0],0,0,0);
    o[d0]=__builtin_amdgcn_mfma_f32_32x32x16_bf16(pa1,PK(1),o[d0],0,0,0);
    o[d0]=__builtin_amdgcn_mfma_f32_32x32x16_bf16(pa2,PK(2),o[d0],0,0,0);
    o[d0]=__builtin_amdgcn_mfma_f32_32x32x16_bf16(pa3,PK(3),o[d0],0,0,0);
    #undef PK
  }
}

#ifndef ATTN_STORE16
#define ATTN_STORE16(p,v) (*(u32x4*)(p)=(v))
#endif
template<int THRL> __device__ __forceinline__ void attn_unit(int b,int h,int qb,const bf16*Q,const bf16*__restrict__ K,const bf16*__restrict__ V,bf16*O,const float*__restrict__ cumg,char*shm,const int tid_){
  const int tid=opaque_v(tid_),lane=tid&63,r32=lane&31,hi=lane>>5; const int wid=__builtin_amdgcn_readfirstlane(tid>>6);
  const long rowbase=(long)b*SEQ; const int q0=qb*QB;
  const bf16*Qw=Q+(rowbase+q0+wid*QBLK)*DM+h*D;
  const bf16*Kh=K+rowbase*DM+h*D,*Vh=V+rowbase*DM+h*D;
  const unsigned lds0=(unsigned)(uintptr_t)shm;
  float*wsf=(float*)(shm+LDS_WS)+wid*64;
  const bf16*ksrc=Kh+(long)lane*DM+wid*8;
  const bf16*vsrc=Vh+(long)(16*(wid&3)+(lane>>2))*DM+(wid>>2)*32+(lane&3)*8;
  const unsigned kdst=lds0+LDS_K+wid*1024, vdst=lds0+LDS_V+wid*1024;
  #define DMA_K(t,slot) glds16(ksrc+(long)(t)*KVBLK*DM,(unsigned)__builtin_amdgcn_readfirstlane(kdst+(slot)))
  #define DMA_V(t,slot) glds16(vsrc+(long)(t)*KVBLK*DM,(unsigned)__builtin_amdgcn_readfirstlane(vdst+(slot)))
  const int vb0=(int)(lds0+LDS_V)+((lane>>4)&1)*32+(lane&3)*8+(4*hi+((lane&15)>>2))*64;
  const char*Kbase=shm+LDS_K; bf16x8 kf[8];
  const lds_cptr shm3=(lds_cptr)shm; const lds_cptr kp0=shm3+LDS_K+hi*1024+r32*16; const lds_cptr vp0=shm3+LDS_V+((lane>>4)&1)*32+(lane&3)*8+(4*hi+((lane&15)>>2))*64;
  const int NT=(q0+QB)/KVBLK;
  typedef float f32x4_t __attribute__((ext_vector_type(4)));
  f32x4_t cumv=f32x4_t{0.f,0.f,0.f,0.f}; if(4*tid<q0+QB)cumv=*reinterpret_cast<const f32x4_t*>(cumg+4*tid);
  float cqm=cumg[q0+wid*QBLK+r32];
  DMA_K(0,0);DMA_V(0,0);DMA_K(1,SLOTB);
  bf16x8 qr[4];
  #pragma unroll
  for(int d0=0;d0<4;++d0)qr[d0]=*reinterpret_cast<const bf16x8*>(&Qw[(long)r32*DM+d0*16+hi*8]);
  float mhat=0.f,l_reg=0.f;f32x16 o[2];o[0]=f32x16{};o[1]=f32x16{};
  const lds_cptr cum3=(lds_cptr)shm+LDS_CUM+hi*16;
  #define CINIT1(C,t,half) do{ const lds_cptr cp_=cum3+(t)*256+(half)*128; \
    _Pragma("unroll") for(int g_=0;g_<4;++g_){ const f32x4_t a_=*(const __attribute__((address_space(3))) f32x4_t*)(cp_+g_*32); \
      _Pragma("unroll") for(int i_=0;i_<4;++i_){ C[4*g_+i_]=cqm-a_[i_]; } } }while(0)
  #define CINIT(C0,C1,t) do{ CINIT1(C0,t,0); CINIT1(C1,t,1); }while(0)
  #define NLD(P,t,half,g) do{ const f32x4_t a_=*(const __attribute__((address_space(3))) f32x4_t*)(cum3+((t)+1)*256+(half)*128+(g)*32); P[4*(g)]=a_[0];P[4*(g)+1]=a_[1];P[4*(g)+2]=a_[2];P[4*(g)+3]=a_[3]; }while(0)
  #define NSB(P,g) do{ P[4*(g)]=cqm-P[4*(g)];P[4*(g)+1]=cqm-P[4*(g)+1];P[4*(g)+2]=cqm-P[4*(g)+2];P[4*(g)+3]=cqm-P[4*(g)+3]; }while(0)
  const int qrel=wid*QBLK+r32;
  #define CMASK(P0,P1,t) do{int jb_=(t)-(NT-4); if(jb_>=0)cmask(P0,P1,jb_,qrel,hi);}while(0)
  bool resc=false;
  #define START(P0,P1) do{ const float rm=rowmax(P0,P1); resc=false; \
    { const float dl=rm; mhat=fadd_s(mhat,dl); \
      _Pragma("unroll") for(int r=0;r<16;++r){P0[r]=fsub_s(P0[r],dl);P1[r]=fsub_s(P1[r],dl);} \
      cqm=fsub_s(cqm,dl); } \
    _Pragma("unroll") for(int r=0;r<16;++r)P0[r]=__builtin_amdgcn_exp2f(P0[r]); }while(0)
  #define RESC() do{ if(resc){ asm volatile("s_waitcnt lgkmcnt(0)":::"memory"); \
      _Pragma("unroll") for(int d_=0;d_<2;++d_) _Pragma("unroll") for(int r=0;r<16;++r)o[d_][r]*=wsf[crow(r,hi)]; } }while(0)
  f32x16 pA0,pA1,pB0,pB1;
  int sl_prev=0,sl_cur=0,sl_next=SLOTB;
  #define ROT() do{sl_prev=sl_cur;sl_cur=sl_next;sl_next=(sl_next==(NSLOT-1)*SLOTB)?0:sl_next+SLOTB;}while(0)
  DMA_K(2,2*SLOTB);
  *reinterpret_cast<f32x4_t*>(shm+LDS_CUM+16*tid)=cumv;
  WAIT_BAR(3);
  CINIT(pA0,pA1,0); qkt(pA0,pA1,Kbase,qr,r32,hi);asm volatile("s_nop 15\n\ts_nop 7":"+v"(pA0),"+v"(pA1));CMASK(pA0,pA1,0);
  START(pA0,pA1);
  CINIT(pB0,pB1,1);
  _Pragma("unroll") for(int r=0;r<16;++r)pA1[r]=__builtin_amdgcn_exp2f(pA1[r]);
  WAIT_BAR(0);
  DMA_K(3,0);DMA_V(1,SLOTB);
  ROT();
  kload8(kf,kp0+sl_cur);
  WAIT_BAR(2);
  s16x4 vlo[8],vhi[8]; u32x4 pw0,pw1,pw2,pw3;
  #define PKW(P,B) cvtpk_s(P[B],P[B+1])
  #define PAF(k) __builtin_bit_cast(bf16x8,pw##k)
  #define VFR(i) (bf16x8){vlo[i][0],vlo[i][1],vlo[i][2],vlo[i][3],vhi[i][0],vhi[i][1],vhi[i][2],vhi[i][3]}
  #define PIN(x) asm volatile("":"+v"(x))
  #define MX3(a,b,c) __builtin_fmaxf(__builtin_fmaxf((a),(b)),(c))
  #define GAPA(MF,A0,A1,A2,A3,W0,W1,PW) do{ MF; sacc+=A0; sacc+=A1; sacc+=A2; sacc+=A3; PIN(sacc); W0; W1; PIN(PW); SBAR(); }while(0)
  #define EX(v) __builtin_amdgcn_exp2f(v)
  #define GAPB(MF,X,B,E) do{ MF; X[B]=EX(X[B]); X[B+1]=EX(X[B+1]); X[B+2]=EX(X[B+2]); X[B+3]=EX(X[B+3]); E; PIN(X); SBAR(); }while(0)
  #define VRD(i) do{ vlo[i]=vtr(vp_+(((i)>>2)*4096+((i)&3)*1024)); vhi[i]=vtr(vp_+(((i)>>2)*4096+((i)&3)*1024+512)); }while(0)
  #define KRD(G,j) do{ if(G){ kload2(kf,kp0+sl_next,j); SBAR(); } }while(0)
  #define STEP(C0,C1,P0,P1,t,GK,GV,GL) do{ SBAR(); \
    const lds_cptr vp_=vp0+sl_prev; \
    VRD(0); SBAR(); float sacc=(P0[0]+P0[1]); \
    GAPA(C0=__builtin_amdgcn_mfma_f32_32x32x16_bf16(kf[0],qr[0],C0,0,0,0), P0[2],P0[3],P0[4],P0[5],     pw0[0]=PKW(P0,0), pw0[1]=PKW(P0,2), pw0); \
    VRD(4); SBAR(); GAPA(C1=__builtin_amdgcn_mfma_f32_32x32x16_bf16(kf[1],qr[0],C1,0,0,0), P0[6],P0[7],P0[8],P0[9],     pw0[2]=PKW(P0,4), pw0[3]=PKW(P0,6), pw0); \
    VRD(1); SBAR(); GAPA(C0=__builtin_amdgcn_mfma_f32_32x32x16_bf16(kf[2],qr[1],C0,0,0,0),   P0[10],P0[11],P0[12],P0[13], pw1[0]=PKW(P0,8), pw1[1]=PKW(P0,10), pw1); \
    VRD(5); SBAR(); GAPA(C1=__builtin_amdgcn_mfma_f32_32x32x16_bf16(kf[3],qr[1],C1,0,0,0),   P0[14],P0[15],P1[0],P1[1],   pw1[2]=PKW(P0,12),pw1[3]=PKW(P0,14), pw1); \
    VRD(2); SBAR(); GAPA(C0=__builtin_amdgcn_mfma_f32_32x32x16_bf16(kf[4],qr[2],C0,0,0,0),   P1[2],P1[3],P1[4],P1[5],     pw2[0]=PKW(P1,0), pw2[1]=PKW(P1,2), pw2); \
    VRD(6); SBAR(); GAPA(C1=__builtin_amdgcn_mfma_f32_32x32x16_bf16(kf[5],qr[2],C1,0,0,0),   P1[6],P1[7],P1[8],P1[9],     pw2[2]=PKW(P1,4), pw2[3]=PKW(P1,6), pw2); \
    VRD(3); SBAR(); GAPA(C0=__builtin_amdgcn_mfma_f32_32x32x16_bf16(kf[6],qr[3],C0,0,0,0),   P1[10],P1[11],P1[12],P1[13], pw3[0]=PKW(P1,8), pw3[1]=PKW(P1,10), pw3); \
    VRD(7); SBAR(); GAPA(C1=__builtin_amdgcn_mfma_f32_32x32x16_bf16(kf[7],qr[3],C1,0,0,0),   P1[14],P1[15],0.f,0.f,       pw3[2]=PKW(P1,12),pw3[3]=PKW(P1,14), pw3); \
    l_reg+=sacc; \
    if(GK){DMA_K((t)+3,sl_cur);} if(GV){DMA_V((t)+1,sl_next);} \
    CMASK(C0,C1,t); \
    { float a=MX3(C0[0],C0[1],C1[0]),b=MX3(C0[2],C0[3],C1[1]); a=MX3(a,C1[2],C1[3]); \
      _Pragma("unroll") for(int r=4;r<16;r+=4){a=MX3(a,C0[r],C0[r+1]);b=MX3(b,C0[r+2],C0[r+3]);a=MX3(a,C1[r],C1[r+1]);b=MX3(b,C1[r+2],C1[r+3]);} \
      float rm=__builtin_fmaxf(a,b); { auto rr=__builtin_amdgcn_permlane32_swap(__float_as_uint(rm),__float_as_uint(rm),false,false); rm=__builtin_fmaxf(__uint_as_float(rr[0]),__uint_as_float(rr[1])); } \
      resc=false; \
      if(__builtin_expect(__any(rm>(float)THRL),0)){ const float dl=__builtin_fmaxf(rm,0.f); mhat+=dl; \
        _Pragma("unroll") for(int r=0;r<16;++r){C0[r]-=dl;C1[r]-=dl;} \
        cqm-=dl; \
        const float f=__builtin_amdgcn_exp2f(-dl); l_reg*=f; if(hi==0)wsf[r32]=f; resc=true; } } \
    SBAR(); \
    GAPB(o[0]=__builtin_amdgcn_mfma_f32_32x32x16_bf16(PAF(0),VFR(0),o[0],0,0,0), C0,0, NLD(P0,t,0,0)); \
    GAPB(o[1]=__builtin_amdgcn_mfma_f32_32x32x16_bf16(PAF(0),VFR(4),o[1],0,0,0), C0,4, NLD(P0,t,0,1); NSB(P0,0)); \
    KRD(GL,0); GAPB(o[0]=__builtin_amdgcn_mfma_f32_32x32x16_bf16(PAF(1),VFR(1),o[0],0,0,0), C0,8, NLD(P0,t,0,2); NSB(P0,1)); \
    KRD(GL,1); GAPB(o[1]=__builtin_amdgcn_mfma_f32_32x32x16_bf16(PAF(1),VFR(5),o[1],0,0,0), C0,12, NLD(P0,t,0,3); NSB(P0,2)); \
    KRD(GL,2); GAPB(o[0]=__builtin_amdgcn_mfma_f32_32x32x16_bf16(PAF(2),VFR(2),o[0],0,0,0), C1,0, NLD(P1,t,1,0); NSB(P0,3)); \
    KRD(GL,3); GAPB(o[1]=__builtin_amdgcn_mfma_f32_32x32x16_bf16(PAF(2),VFR(6),o[1],0,0,0), C1,4, NLD(P1,t,1,1); NSB(P1,0)); \
    GAPB(o[0]=__builtin_amdgcn_mfma_f32_32x32x16_bf16(PAF(3),VFR(3),o[0],0,0,0), C1,8, NLD(P1,t,1,2); NSB(P1,1)); \
    GAPB(o[1]=__builtin_amdgcn_mfma_f32_32x32x16_bf16(PAF(3),VFR(7),o[1],0,0,0), C1,12, NLD(P1,t,1,3); NSB(P1,2)); NSB(P1,3); SBAR(); \
    }while(0)
  int t=1;
  #undef CMASK
  #define CMASK(P0,P1,t) do{}while(0)
  for(;t+5<NT;t+=2){
    STEP(pB0,pB1,pA0,pA1,t,true,true,true);     WAIT_BAR(2); RESC(); ROT();
    STEP(pA0,pA1,pB0,pB1,t+1,true,true,true);   WAIT_BAR(2); RESC(); ROT();
  }
  #undef CMASK
  #define CMASK(P0,P1,t) do{int jb_=(t)-(NT-4); if(jb_>=0)cmask(P0,P1,jb_,qrel,hi);}while(0)
  #define ENDW(tt) do{ if((tt)+3<NT){WAIT_BAR(2);} else if((tt)+2<NT){WAIT_BAR(1);} else {WAIT_BAR(0);} }while(0)
  for(;t+1<NT;t+=2){
    STEP(pB0,pB1,pA0,pA1,t,(t+3<NT),(t+1<NT),(t+1<NT));       ENDW(t);   RESC(); ROT();
    STEP(pA0,pA1,pB0,pB1,t+1,(t+4<NT),(t+2<NT),(t+2<NT));     ENDW(t+1); RESC(); ROT();
  }
  STEP(pB0,pB1,pA0,pA1,NT-1,false,false,false); RESC();
  { float sacc=pB0[0]+pB0[1]; _Pragma("unroll") for(int r=2;r<16;++r)sacc+=pB0[r]; _Pragma("unroll") for(int r=0;r<16;++r)sacc+=pB1[r]; l_reg+=sacc;
    pw0=(u32x4){PKW(pB0,0),PKW(pB0,2),PKW(pB0,4),PKW(pB0,6)};pw1=(u32x4){PKW(pB0,8),PKW(pB0,10),PKW(pB0,12),PKW(pB0,14)};pw2=(u32x4){PKW(pB1,0),PKW(pB1,2),PKW(pB1,4),PKW(pB1,6)};pw3=(u32x4){PKW(pB1,8),PKW(pB1,10),PKW(pB1,12),PKW(pB1,14)};
    SBAR(); pv(o,vb0+sl_cur,PAF(0),PAF(1),PAF(2),PAF(3)); }
  #undef PKW
  #undef PAF
  #undef VFR
  #undef PIN
  #undef MX3
  #undef GAPA
  #undef GAPB
  #undef EX
  #undef VRD
  #undef KRD
  #undef STEP
  #undef ENDW
  {auto rr=__builtin_amdgcn_permlane32_swap(__float_as_uint(l_reg),__float_as_uint(l_reg),false,false);l_reg=__uint_as_float(rr[0])+__uint_as_float(rr[1]);}
  if(hi==0)wsf[32+r32]=l_reg;asm volatile("s_waitcnt lgkmcnt(0)":::"memory");
  float rli[16];
  #pragma unroll
  for(int r=0;r<16;++r)rli[r]=__builtin_amdgcn_rcpf(wsf[32+crow(r,hi)]);
  bf16*Ow=O+(rowbase+q0+wid*QBLK)*OPITCH+h*D;
  { bf16*stg=(bf16*)(shm+LDS_OST)+wid*2048;
    #pragma unroll
    for(int r=0;r<16;++r){const int orow=crow(r,hi);
      #pragma unroll
      for(int d0=0;d0<2;++d0)stg[orow*64+d0*32+r32]=__float2bfloat16(o[d0][r]*rli[r]);}
    asm volatile("s_waitcnt lgkmcnt(0)":::"memory");
    #pragma unroll
    for(int i=0;i<4;++i){const int row=i*8+(lane>>3),ch=lane&7; const u32x4 v=*(const u32x4*)(stg+row*64+ch*8); ATTN_STORE16(Ow+(long)row*OPITCH+ch*8,v);} }
  asm volatile("s_waitcnt lgkmcnt(0)\n\ts_barrier":::"memory");
  #undef DMA_K
  #undef DMA_V
  #undef CMASK
  #undef START
  #undef RESC
  #undef ROT
  #undef CINIT
  #undef CINIT1
  #undef NLD
  #undef NSB
}
constexpr int ATTN_LDS_BYTES=LDS_BYTES;
#undef SBAR
#undef WAIT_BAR
}

constexpr size_t WS_CUM = 10 * MiB;
__device__ __forceinline__ void cum_item(Frame& F, int hb, int c) {
    unsigned char* const ws_ = F.wsp();
    const int tid = F.tid, lane = F.lane, w = F.wave;
    const float* flog = (const float*)(ws_ + WS_FLOG) + ((size_t)(hb * BH + (c >> 3)) * SEQ) * 8 + (c & 7);
    float* cumg = (float*)(ws_ + WS_CUM) + (size_t)c * SEQ;
    LAS float* red = (LAS float*)F.lds;
    float v[4]; float s = 0.f;
#pragma unroll
    for (int i = 0; i < 4; ++i) { v[i] = flog[(size_t)(4 * tid + i) * 8] * 1.4426950408889634f; s += v[i]; v[i] = s; }
    float inc = s;
#pragma unroll
    for (int o = 1; o < 64; o <<= 1) { const float y = __int_as_float(__builtin_amdgcn_ds_bpermute(((lane - o) & 63) << 2, __float_as_int(inc))); if (lane >= o) inc += y; }
    if (lane == 63) red[w] = inc;
    __syncthreads();
    float base = inc - s;
    for (int ww = 0; ww < w; ++ww) base += red[ww];
    *(f32x4*)(cumg + 4 * tid) = (f32x4){base + v[0], base + v[1], base + v[2], base + v[3]};
    __syncthreads();
}

__device__ __forceinline__ void phase_rf(Frame& F, int l, int hb, const bool xb  ) {
    unsigned char* const ws_ = F.wsp(); float* const out_ = F.outp();
    LAS float* wrt = (LAS float*)F.lds;
    LAS int* hist = (LAS int*)(F.lds + HIST_OFF);
    { const float* wr_ = F.in[I_WROUTER];
#pragma unroll 8
      for (int i = F.tid; i < 16384; i += 512) { const int k = i >> 4, e = i & 15; wrt[e * 1024 + k] = wr_[i]; } }
    if (F.tid < 16) hist[F.tid] = 0;
    __syncthreads();
    const float* xsrc = F.in[I_X];
    const float* ada = (const float*)(ws_ + WS_ADA) + (size_t)l * 32 * 6144;
    const bf16_t* HO = (const bf16_t*)(ws_ + WS_HOUT); unsigned char* U2 = ws_ + WS_U2;
    int* ridx = (int*)(ws_ + WS_RIDX); float* rw = (float*)(ws_ + WS_RW);
    const float* lg = F.in[I_LN1G] + l * D; const float* lb = F.in[I_LN1B] + l * D; const float* brt = F.in[I_BROUTER];
    constexpr int RB = 4;
    for (int it = 0; it < SEGROWS / NWAVES / RB; ++it) {
        const int rl0 = F.bid * SEGROWS + F.wave * (SEGROWS / NWAVES) + it * RB, row0 = hb * TH + rl0, b = row0 >> 11;
        const float* ab = ada + (size_t)b * 6144;
        f32x4 v[RB][4]; float sm[RB];
#pragma unroll
        for (int r = 0; r < RB; ++r) sm[r] = 0.f;
#pragma unroll
        for (int j = 0; j < 4; ++j) { const f32x4 g1 = *((const f32x4*)(ab + 2 * D) + F.lane + 64 * j);
#pragma unroll
            for (int r = 0; r < RB; ++r) { f32x4 x; if (xb) x = bf4_to_f32(*((const u32x2*)((const unsigned char*)out_ + (size_t)(row0 + r) * 4096) + F.lane + 64 * j)); else x = *((const f32x4*)(xsrc + (size_t)(row0 + r) * D) + F.lane + 64 * j);
                const unsigned long long hw = *((const unsigned long long*)(HO + (size_t)(rl0 + r) * D) + F.lane + 64 * j);
                const unsigned h0 = (unsigned)hw, h1 = (unsigned)(hw >> 32);
                v[r][j] = (f32x4){DN_ALPHA * x.x + g1.x * bflo(h0), DN_ALPHA * x.y + g1.y * bfhi(h0), DN_ALPHA * x.z + g1.z * bflo(h1), DN_ALPHA * x.w + g1.w * bfhi(h1)};
                sm[r] += (v[r][j].x + v[r][j].y) + (v[r][j].z + v[r][j].w); } }
        wave_sum_n<RB>(sm);
        float sq[RB];
#pragma unroll
        for (int r = 0; r < RB; ++r) { const float mean = sm[r] * (1.f / D); sq[r] = 0.f;
#pragma unroll
            for (int j = 0; j < 4; ++j) { v[r][j] = v[r][j] - mean; sq[r] += (v[r][j].x * v[r][j].x + v[r][j].y * v[r][j].y) + (v[r][j].z * v[r][j].z + v[r][j].w * v[r][j].w); } }
        wave_sum_n<RB>(sq);
#pragma unroll
        for (int r = 0; r < RB; ++r) { const float rstd = 1.f / sqrtf(sq[r] * (1.f / D) + LN_EPS); sm[r] = 0.f;
#pragma unroll
            for (int j = 0; j < 4; ++j) { const f32x4 g = *((const f32x4*)lg + F.lane + 64 * j), bb = *((const f32x4*)lb + F.lane + 64 * j); v[r][j] = v[r][j] * rstd * g + bb;
                *((u32x2*)((unsigned char*)out_ + (size_t)(row0 + r) * 4096 + 2048) + F.lane + 64 * j) = (u32x2){pk2(v[r][j].x, v[r][j].y), pk2(v[r][j].z, v[r][j].w)};
                sm[r] += (v[r][j].x + v[r][j].y) + (v[r][j].z + v[r][j].w); } }
        wave_sum_n<RB>(sm);
#pragma unroll
        for (int r = 0; r < RB; ++r) { const float mean = sm[r] * (1.f / D); sq[r] = 0.f;
#pragma unroll
            for (int j = 0; j < 4; ++j) { v[r][j] = v[r][j] - mean; sq[r] += (v[r][j].x * v[r][j].x + v[r][j].y * v[r][j].y) + (v[r][j].z * v[r][j].z + v[r][j].w * v[r][j].w); } }
        wave_sum_n<RB>(sq);
        float rstd2[RB];
#pragma unroll
        for (int r = 0; r < RB; ++r) rstd2[r] = 1.f / sqrtf(sq[r] * (1.f / D) + LN_EPS);
        float lgt[RB * 16];
#pragma unroll
        for (int i = 0; i < RB * 16; ++i) lgt[i] = 0.f;
#pragma unroll
        for (int j = 0; j < 4; ++j) { const f32x4 sh = *((const f32x4*)(ab + 3 * D) + F.lane + 64 * j), sc = *((const f32x4*)(ab + 4 * D) + F.lane + 64 * j) + 1.f;
            f32x4 u[RB];
#pragma unroll
            for (int r = 0; r < RB; ++r) { u[r] = v[r][j] * rstd2[r] * sc + sh;
                *((unsigned*)(U2 + (size_t)(row0 + r) * D) + F.lane + 64 * j) = pk4_fp8(u[r].x * FP8_SX, u[r].y * FP8_SX, u[r].z * FP8_SX, u[r].w * FP8_SX); }
#pragma unroll
            for (int e = 0; e < 16; ++e) { const f32x4 wv = *(const LAS f32x4*)(wrt + e * 1024 + 256 * j + 4 * F.lane);
#pragma unroll
                for (int r = 0; r < RB; ++r) lgt[r * 16 + e] += (u[r].x * wv.x + u[r].y * wv.y) + (u[r].z * wv.z + u[r].w * wv.w); } }
        float sgl[RB], sell[RB];
        { const float brl = brt[(F.lane >> 2) & 15];
#pragma unroll
          for (int r = 0; r < RB; ++r) { const float (&vv)[16] = *reinterpret_cast<const float (*)[16]>(&lgt[r * 16]); const float z = rs16(vv, F.lane); sgl[r] = 1.f / (1.f + expf(-z)); sell[r] = sgl[r] + brl; } }
#pragma unroll
        for (int r = 0; r < RB; ++r) {
            float sg[16], sel[16];
#pragma unroll
            for (int e = 0; e < 16; ++e) { sg[e] = lane_bcast(sgl[r], 4 * e); sel[e] = lane_bcast(sell[r], 4 * e); }
            int bg = 0; float bgs = -INFINITY;
#pragma unroll
            for (int g = 0; g < 4; ++g) { float m1 = -INFINITY, m2 = -INFINITY;
#pragma unroll
                for (int q = 0; q < 4; ++q) { const float x = sel[4 * g + q]; if (x > m1) { m2 = m1; m1 = x; } else if (x > m2) m2 = x; }
                const float gs = m1 + m2; if (gs > bgs) { bgs = gs; bg = g; } }
            int i1 = 0, i2 = 0; float m1 = -INFINITY, m2 = -INFINITY, s1 = 0.f, s2v = 0.f;
#pragma unroll
            for (int g = 0; g < 4; ++g) if (g == bg) {
#pragma unroll
                for (int q = 0; q < 4; ++q) { const float x = sel[4 * g + q], sv = sg[4 * g + q];
                    if (x > m1) { m2 = m1; i2 = i1; s2v = s1; m1 = x; i1 = 4 * g + q; s1 = sv; } else if (x > m2) { m2 = x; i2 = 4 * g + q; s2v = sv; } } }
            if (F.lane == 0) { const float inv = 1.f / (s1 + s2v); const int row = row0 + r;
                ridx[(size_t)row * 2] = i1; ridx[(size_t)row * 2 + 1] = i2; rw[(size_t)row * 2] = s1 * inv; rw[(size_t)row * 2 + 1] = s2v * inv;
                atomicAdd((int*)&hist[i1], 1); atomicAdd((int*)&hist[i2], 1); }
        }
    }
    __syncthreads();
    if (F.tid < 16) ((int*)(ws_ + WS_SEGCNT))[(hb * 256 + F.bid) * 16 + F.tid] = hist[F.tid];
    __syncthreads();
}

__device__ __forceinline__ int wave_sum_i(int v) {
    v += __builtin_amdgcn_ds_swizzle(v, SWZ_XOR(1)); v += __builtin_amdgcn_ds_swizzle(v, SWZ_XOR(2)); v += __builtin_amdgcn_ds_swizzle(v, SWZ_XOR(4));
    v += __builtin_amdgcn_ds_swizzle(v, SWZ_XOR(8)); v += __builtin_amdgcn_ds_swizzle(v, SWZ_XOR(16));
    auto rr = __builtin_amdgcn_permlane32_swap((unsigned)v, (unsigned)v, false, false); return (int)(rr[0] + rr[1]);
}
__device__ __forceinline__ void moe_tables(Frame& F, int seg_a, int seg_b, LAS int* base_ab  ) {
    unsigned char* const ws_ = F.wsp();
    LAS int* sc = (LAS int*)F.lds;
    LAS int* pexp = (LAS int*)(F.lds + PEXP_OFF);
    LAS int* tmp = (LAS int*)(F.lds + 32768);
    const int* segcnt = (const int*)(ws_ + WS_SEGCNT);
#pragma unroll 8
    for (int i = F.tid; i < NSEG * 16; i += 512) sc[i] = segcnt[i];
    __syncthreads();
#pragma unroll
    for (int ee = 0; ee < 2; ++ee) { const int e = 2 * F.wave + ee; int tot = 0, pa = 0, pb = 0;
#pragma unroll
        for (int q = 0; q < 8; ++q) { const int sgm = F.lane + 64 * q; const int c = sc[sgm * 16 + e]; tot += c; pa += (sgm < seg_a) ? c : 0; pb += (sgm < seg_b) ? c : 0; }
        tot = wave_sum_i(tot); pa = wave_sum_i(pa); pb = wave_sum_i(pb);
        if (F.lane == 0) { tmp[e] = tot; tmp[16 + e] = pa; tmp[32 + e] = pb; } }
    __syncthreads();
    if (F.tid == 0) { int p = 0;
#pragma unroll
        for (int e = 0; e < 16; ++e) { tmp[48 + e] = p * 256; tmp[64 + e] = p; p += (tmp[e] + 255) >> 8; }
        pexp[NPMAX] = p; }
    __syncthreads();
    for (int t = F.tid; t < NPMAX; t += 512) { int e = 0;
#pragma unroll
        for (int q = 1; q < 16; ++q) e += (t >= tmp[64 + q]) ? 1 : 0;
        pexp[t] = e; }
    if (base_ab && F.tid < 32) base_ab[F.tid] = tmp[48 + (F.tid & 15)] + tmp[16 + F.tid];
    __syncthreads();
}

__device__ __forceinline__ void phase_rg(Frame& F) {
    unsigned char* const ws_ = F.wsp(); float* const out_ = F.outp(); (void)ws_; (void)out_;
    LAS int* base_ab = (LAS int*)(F.lds + 36864);
    LAS int* epos = (LAS int*)(F.lds + 40960);
    moe_tables(F, F.bid, 256 + F.bid, base_ab);
    const int* ridx = (const int*)(ws_ + WS_RIDX); int* rpos = (int*)(ws_ + WS_RPOS);
    if (F.wave < 2) { const int seg = F.wave * 256 + F.bid; int run[16];
#pragma unroll
        for (int e = 0; e < 16; ++e) run[e] = base_ab[F.wave * 16 + e];
        for (int ch = 0; ch < 4; ++ch) { const int ent = ch * 64 + F.lane; const int row = seg * SEGROWS + (ent >> 1); const int me = ridx[(size_t)row * 2 + (ent & 1)]; int pos = 0;
#pragma unroll
            for (int e = 0; e < 16; ++e) { const unsigned long long mask = __ballot(me == e); if (me == e) pos = run[e] + __popcll(mask & ((1ull << F.lane) - 1ull)); run[e] += __popcll(mask); }
            epos[F.wave * 256 + ent] = pos; rpos[(size_t)row * 2 + (ent & 1)] = pos; } }
    __syncthreads();
    const unsigned char* U2 = ws_ + WS_U2; unsigned char* XS = ws_ + WS_XS;
    for (int i0 = F.wave * 64; i0 < F.wave * 64 + 64; i0 += 16) {
        u32x4 a[8]; int pos[16];
#pragma unroll
        for (int q = 0; q < 8; ++q) { const int i = i0 + 2 * q, sg = i >> 8, ent = i & 255; const int row = (sg * 256 + F.bid) * SEGROWS + (ent >> 1); pos[2 * q] = epos[i]; pos[2 * q + 1] = epos[i + 1];
            a[q] = *((const u32x4*)(U2 + (size_t)row * D) + F.lane); }
#pragma unroll
        for (int q = 0; q < 8; ++q) { *((u32x4*)(XS + (size_t)pos[2 * q] * D) + F.lane) = a[q]; *((u32x4*)(XS + (size_t)pos[2 * q + 1] * D) + F.lane) = a[q]; } }
    __syncthreads();
}

__device__ __forceinline__ void phase_rj(Frame& F, int l, const bool fuse_next  ) {
    unsigned char* const ws_ = F.wsp(); float* const out_ = F.outp();
    if (fuse_next) stage_wff(F, l + 1);
    const LAS float* wff = (const LAS float*)F.lds;
    const float* ada_n = (const float*)(ws_ + WS_ADA) + (size_t)(l + 1) * 32 * 6144; unsigned char* UF8 = ws_ + WS_HOUT; float* flog = (float*)(ws_ + WS_FLOG); const float* bfg_n = F.in[I_BFORGET] + (l + 1) * 8;
    const float* ada = (const float*)(ws_ + WS_ADA) + (size_t)l * 32 * 6144;
    const unsigned char* Y = ws_ + WS_XS;   const int* rpos = (const int*)(ws_ + WS_RPOS); const float* rw = (const float*)(ws_ + WS_RW);
    const float* lg = F.in[I_LN2G] + l * D; const float* lb = F.in[I_LN2B] + l * D;
    const int gw = F.bid * NWAVES + F.wave, NGW = F.G * NWAVES;
    constexpr int RB = 4;
    for (int row0 = gw * RB; row0 < T; row0 += NGW * RB) { const int b = row0 >> 11;
        int p0[RB], p1[RB]; float w0[RB], w1[RB];
#pragma unroll
        for (int r = 0; r < RB; ++r) { p0[r] = rpos[(size_t)(row0 + r) * 2]; p1[r] = rpos[(size_t)(row0 + r) * 2 + 1]; w0[r] = rw[(size_t)(row0 + r) * 2] * (1.f / FP8_SY); w1[r] = rw[(size_t)(row0 + r) * 2 + 1] * (1.f / FP8_SY); }
        f32x4 v[RB][4]; float sm[RB];
#pragma unroll
        for (int r = 0; r < RB; ++r) sm[r] = 0.f;
#pragma unroll
        for (int j = 0; j < 4; ++j) { const f32x4 g2 = *((const f32x4*)(ada + (size_t)b * 6144 + 5 * D) + F.lane + 64 * j);
#pragma unroll
            for (int r = 0; r < RB; ++r) { const f32x4 x = bf4_to_f32(*((const u32x2*)((const unsigned char*)out_ + (size_t)(row0 + r) * 4096 + 2048) + F.lane + 64 * j));
                const int a = *((const int*)(Y + (size_t)p0[r] * D) + F.lane + 64 * j), c = *((const int*)(Y + (size_t)p1[r] * D) + F.lane + 64 * j);
                const f32x2 alo = __builtin_amdgcn_cvt_pk_f32_fp8(a, false), ahi = __builtin_amdgcn_cvt_pk_f32_fp8(a, true), clo = __builtin_amdgcn_cvt_pk_f32_fp8(c, false), chi = __builtin_amdgcn_cvt_pk_f32_fp8(c, true);
                v[r][j] = (f32x4){DN_ALPHA * x.x + g2.x * (w0[r] * alo.x + w1[r] * clo.x), DN_ALPHA * x.y + g2.y * (w0[r] * alo.y + w1[r] * clo.y),
                                  DN_ALPHA * x.z + g2.z * (w0[r] * ahi.x + w1[r] * chi.x), DN_ALPHA * x.w + g2.w * (w0[r] * ahi.y + w1[r] * chi.y)};
                sm[r] += (v[r][j].x + v[r][j].y) + (v[r][j].z + v[r][j].w); } }
        wave_sum_n<RB>(sm);
        float sq[RB];
#pragma unroll
        for (int r = 0; r < RB; ++r) { const float mean = sm[r] * (1.f / D); sq[r] = 0.f;
#pragma unroll
            for (int j = 0; j < 4; ++j) { v[r][j] = v[r][j] - mean; sq[r] += (v[r][j].x * v[r][j].x + v[r][j].y * v[r][j].y) + (v[r][j].z * v[r][j].z + v[r][j].w * v[r][j].w); } }
        wave_sum_n<RB>(sq);
#pragma unroll
        for (int r = 0; r < RB; ++r) { const float rstd = 1.f / sqrtf(sq[r] * (1.f / D) + LN_EPS);
#pragma unroll
            for (int j = 0; j < 4; ++j) { const f32x4 g = *((const f32x4*)lg + F.lane + 64 * j), bb = *((const f32x4*)lb + F.lane + 64 * j);
                v[r][j] = v[r][j] * rstd * g + bb;
                if (fuse_next) *((u32x2*)((unsigned char*)out_ + (size_t)(row0 + r) * 4096) + F.lane + 64 * j) = (u32x2){pk2(v[r][j].x, v[r][j].y), pk2(v[r][j].z, v[r][j].w)};
                else *((f32x4*)(out_ + (size_t)(row0 + r) * D) + F.lane + 64 * j) = v[r][j]; } }
        if (fuse_next) { const bool h1 = row0 >= TH; ra_math(v, h1 ? row0 - TH : row0, row0, F.lane, ada_n, h1 ? ws_ + WS_UF8_H1 : UF8, flog, bfg_n, wff); }
    }
}

#ifndef PHASE_MASK
#define PHASE_MASK 0xFFFF
#endif
#define PH_ON (ph >= lo && ph < hi)
#define SITE(k) (PH_ON && ((PHASE_MASK >> (k)) & 1))
#define LOCALF Frame F = F0; F.wave = opaque_s(F0.wave); F.lane = opaque_v((int)__builtin_amdgcn_mbcnt_hi(~0u, __builtin_amdgcn_mbcnt_lo(~0u, 0u))); F.tid = F.wave * 64 + F.lane; F.bid = opaque_s(F0.bid); F.G = opaque_s(F0.G)
#define PH_END do { if (MK_ONE_LAUNCH && ph >= lo && ph + 1 < hi) xcd_barrier(bar, F0.wave == 0 && __builtin_amdgcn_mbcnt_hi(~0u, __builtin_amdgcn_mbcnt_lo(~0u, 0u)) == 0u); ++ph; } while (0)

template <int l_, int hb_> __device__ __forceinline__ void half_phases(const Frame& F0, const XcdBarrier& bar, int& ph, const int lo, const int hi) {

            if constexpr (l_ == 0 && hb_ == 0) {
            if (SITE(1)) { LOCALF; const int l = opaque_s(l_); for (int hb = 0; hb < opaque_s(NHALF); ++hb) phase_ra(F, l, hb, hb == 0); }
            PH_END;
            }
            if (SITE(2)) { LOCALF; const int l = opaque_s(l_), hb = opaque_s(hb_); (void)l; (void)hb;
                if (F.bid < 128) cum_item(F, hb, F.bid);
                unsigned char* const ws = F.wsp(); const bf16_t* wcat = (const bf16_t*)(ws + WS_WSMALL + (size_t)l * WSMALL_LAYER);
                pg8::EpiZG E{(bf16_t*)(ws + WS_Z), (bf16_t*)(ws + WS_G), F.in[I_BGATE] + l * GC, 0, 1.f / (FP8_SX * FP8_SW13)};
                { pg8::Gemm g{(const bf16_t*)(ws + (hb ? WS_UF8_H1 : WS_HOUT)), wcat, D / 2, 0}; pg8::StaticOrder S; S.init(TH, N1, F.G, F.bid);
                  pg8::gemm_phase<pg8::EpiZG, pg8::StaticOrder, true>(F.lds, F.tid, g, S, E); }
            }
            PH_END;
            if (SITE(3)) { LOCALF; const int l = opaque_s(l_), hb = opaque_s(hb_); (void)l; (void)hb;
                ret_a_run(F, BH * 4 * 32);
                const int bhl = F.bid >> 1, odd = F.bid & 1;
                for (int i = 0; i < 4; ++i) { const int qb = odd ? (i == 0 ? 6 : i == 1 ? 5 : i == 2 ? 2 : 1) : (i == 0 ? 7 : i == 1 ? 4 : i == 2 ? 3 : 0);
                    unsigned char* const ws = F.wsp(); const attn_body::bf16* Zb = (const attn_body::bf16*)(ws + WS_Z);
                    attn_body::attn_unit<8>(bhl >> 3, bhl & 7, qb, Zb + C_FQ, Zb + C_FK, Zb + C_FV, (attn_body::bf16*)(ws + WS_ACT) + 1024, (const float*)(ws + WS_CUM) + (size_t)bhl * SEQ, (char*)F.lds, F.tid); }
                for (int it = F.bid; it < 512; it += F.G) { __syncthreads(); conv_unit(F, l, it); }
            }
            PH_END;
            if (SITE(12)) { LOCALF; const int l = opaque_s(l_), hb = opaque_s(hb_); (void)l; (void)hb;
                ret_c_run(F);
            }
            PH_END;
            if (SITE(4)) { LOCALF; const int l = opaque_s(l_), hb = opaque_s(hb_); (void)l; (void)hb;
                unsigned char* const ws = F.wsp(); const bf16_t* wmerge = (const bf16_t*)(ws + WS_WSMALL + (size_t)l * WSMALL_LAYER) + (size_t)N1 * D;
                pg8::Gemm g{(const bf16_t*)(ws + WS_ACT), wmerge, ACTC, 0}; pg8::StaticOrder S; S.init(TH, D, F.G, F.bid);
                pg8::EpiMerge E{(const unsigned char*)(ws + WS_G), (bf16_t*)(ws + WS_U)};
                pg8::gemm_phase<pg8::EpiMerge, pg8::StaticOrder>(F.lds, F.tid, g, S, E);
            }
            PH_END;
            if (SITE(5)) { LOCALF; const int l = opaque_s(l_), hb = opaque_s(hb_); (void)l; (void)hb;
                unsigned char* const ws = F.wsp(); const bf16_t* wo = (const bf16_t*)(ws + WS_WSMALL + (size_t)l * WSMALL_LAYER) + (size_t)N1 * D + (size_t)D * ACTC;
                pg8::Gemm g{(const bf16_t*)(ws + WS_U), wo, D / 2, 0}; pg8::StaticOrder S; S.init(TH, D, F.G, F.bid);
                pg8::EpiBf16 E{(bf16_t*)(ws + WS_HOUT), D, 1.f / (FP8_SX * FP8_SW13), 0};
                pg8::gemm_phase<pg8::EpiBf16, pg8::StaticOrder, true>(F.lds, F.tid, g, S, E);
            }
            PH_END;
            if (SITE(6)) { LOCALF; const int l = opaque_s(l_), hb = opaque_s(hb_); (void)l; (void)hb; phase_rf(F, l, hb, l_ > 0); }
            PH_END;
}
template <int l_> __device__ __forceinline__ void moe_phases(const Frame& F0, const XcdBarrier& bar, int& ph, const int lo, const int hi) {
        if (SITE(7)) { LOCALF; const int l = opaque_s(l_); (void)l; phase_rg(F); }
        PH_END;
        if (SITE(8)) { LOCALF; const int l = opaque_s(l_); (void)l;
            moe_tables(F, -1, -1, nullptr);
            const LAS int* pexp = (const LAS int*)(F.lds + PEXP_OFF);
            unsigned char* const ws = F.wsp();
            pg8::Gemm g{(const bf16_t*)(ws + WS_XS), (const bf16_t*)(ws + WS_W13), D / 2, (size_t)4096 * D};
            pg8::MoeOrder S{16, F.G, F.bid, __builtin_amdgcn_readfirstlane(pexp[NPMAX]), pexp, 4, 8};
            pg8::EpiSwiGLU E{ws + WS_H};
            pg8::gemm_phase<pg8::EpiSwiGLU, pg8::MoeOrder, true>(F.lds, F.tid, g, S, E);
        }
        PH_END;
        if (SITE(9)) { LOCALF; const int l = opaque_s(l_); (void)l;
            moe_tables(F, -1, -1, nullptr);
            const LAS int* pexp = (const LAS int*)(F.lds + PEXP_OFF);
            unsigned char* const ws = F.wsp();
            pg8::Gemm g{(const bf16_t*)(ws + WS_H), (const bf16_t*)(ws + WS_W2), FF / 2, (size_t)D * FF};
            pg8::MoeOrder S{4, F.G, F.bid, __builtin_amdgcn_readfirstlane(pexp[NPMAX]), pexp, 8, 4};
            pg8::EpiBf16 E{(bf16_t*)(ws + WS_XS), D, FP8_SY / (FP8_SH * FP8_SW2), 1};
            pg8::gemm_phase<pg8::EpiBf16, pg8::MoeOrder, true>(F.lds, F.tid, g, S, E);
        }
        PH_END;
        if (SITE(10)) { LOCALF; const int l = opaque_s(l_); (void)l; const int gw = F.bid * NWAVES + F.wave, NGW = F.G * NWAVES;
            phase_rj(F, l, l_ + 1 < DEPTH);
            if (l + 1 < DEPTH) { __syncthreads(); convert_moe(F, l + 1, gw, NGW); }
        }
        PH_END;
}
constexpr int PH_PER_HALF = 7, PH_PER_LAYER = NHALF * PH_PER_HALF + 4, NPHASES = 1 + DEPTH * PH_PER_LAYER;
__global__ void __launch_bounds__(NWAVES * 64, 2) trunk_fwd(Args args) {
    extern __shared__ __attribute__((aligned(16))) unsigned char lds[];
    Frame F0;
    F0.lds = (LAS unsigned char*)lds;
    F0.tid = threadIdx.x; F0.lane = F0.tid & 63; F0.wave = __builtin_amdgcn_readfirstlane(F0.tid >> 6);
    F0.G = gridDim.x; F0.bid = blockIdx.x; F0.in.p = (const LAS unsigned long long*)(F0.lds + PTAB_OFF);
    volatile LAS unsigned* MISC = (volatile LAS unsigned*)(F0.lds + MISC_OFF);
    for (int u = F0.tid; u < (LDS_BYTES - LDSCTL_OFF) / 4; u += NWAVES * 64) ((LAS unsigned*)(F0.lds + LDSCTL_OFF))[u] = 0u;
    __syncthreads();
    if (F0.tid < 25) ((LAS unsigned long long*)(F0.lds + PTAB_OFF))[F0.tid] = (unsigned long long)args.in[F0.tid];
    if (F0.tid == 25) ((LAS unsigned long long*)(F0.lds + PTAB_OFF))[25] = (unsigned long long)args.out;
    if (F0.tid == 26) ((LAS unsigned long long*)(F0.lds + PTAB_OFF))[26] = (unsigned long long)args.ws;
    __syncthreads();
    gu32* ctl = (gu32*)(args.ws + WS_CTL);
    XcdBarrier bar; bar.bar = (unsigned*)(ctl + CW_BAR); bar.x = 0; bar.st = nullptr;
    if (MK_ONE_LAUNCH) bar = xcd_barrier_post((unsigned*)(ctl + CW_BAR), MISC + 8, F0.tid == 0);
    const int lo = args.ph_lo, hi = args.ph_hi;
    int ph = 0;

    if (SITE(0)) { LOCALF; const int gw = F.bid * NWAVES + F.wave, NGW = F.G * NWAVES;
        convert_small(F, 0, gw, NGW); convert_small(F, 1, gw, NGW); convert_moe(F, 0, gw, NGW);
        { float* rotc = (float*)(F.wsp() + WS_ROT); float* rots = rotc + 2048 * 32;
          for (int i = F.bid * 512 + F.tid; i < 2048 * 32; i += F.G * 512) { const int t = i >> 5, j = i & 31; const float inv = powf(10000.f, -(float)j / 32.f); const float ang = (float)t * inv; rotc[i] = cosf(ang); rots[i] = sinf(ang); } }
        __syncthreads();
        if (F.bid < 192) ada_item(F, F.bid);
    }
    PH_END;

    half_phases<0, 0>(F0, bar, ph, lo, hi); half_phases<0, 1>(F0, bar, ph, lo, hi); moe_phases<0>(F0, bar, ph, lo, hi);
    half_phases<1, 0>(F0, bar, ph, lo, hi); half_phases<1, 1>(F0, bar, ph, lo, hi); moe_phases<1>(F0, bar, ph, lo, hi);
#undef PH_ON
#undef SITE
#undef PH_END
}

extern "C" void kernel_launch(void* const* d_in, const int* in_sizes, int n_in, void* d_out, int out_size, void* d_ws, size_t ws_size, hipStream_t stream) {
    static int grid = 0;
    if (grid == 0) {
        if (n_in != 25 || out_size != T * D || ws_size < WS_END) { fprintf(stderr, "kernel_launch: unexpected problem (n_in %d out %d ws %zu)\n", n_in, out_size, ws_size); grid = -1; return; }
        int dev = 0, cus = 0, per_cu = 0;
        if (hipGetDevice(&dev) != hipSuccess || hipDeviceGetAttribute(&cus, hipDeviceAttributeMultiprocessorCount, dev) != hipSuccess) { grid = -1; return; }
        if (hipFuncSetAttribute((const void*)trunk_fwd, hipFuncAttributeMaxDynamicSharedMemorySize, LDS_BYTES) != hipSuccess) { grid = -1; return; }
        if (hipOccupancyMaxActiveBlocksPerMultiprocessor(&per_cu, (const void*)trunk_fwd, NWAVES * 64, LDS_BYTES) != hipSuccess || per_cu < 1)
            fprintf(stderr, "kernel_launch: occupancy query reports %d\n", per_cu);
        (void)hipGetLastError();
        grid = cus;
        if (grid != 256) fprintf(stderr, "kernel_launch: %d CUs (built for 256)\n", grid);
    }
    if (grid < 0) return;
    if (hipMemsetAsync((char*)d_ws + WS_CTL, 0, CTL_ZERO_BYTES, stream) != hipSuccess) return;
    Args a{};
    for (int i = 0; i < 25; ++i) a.in[i] = (const float*)d_in[i];
    a.out = (float*)d_out; a.ws = (unsigned char*)d_ws;
#if MK_ONE_LAUNCH
    a.ph_lo = 0; a.ph_hi = NPHASES;
    hipLaunchKernelGGL(trunk_fwd, dim3(grid), dim3(NWAVES * 64), LDS_BYTES, stream, a);
#else
    for (int p = 0; p < NPHASES; ++p) { a.ph_lo = p; a.ph_hi = p + 1; hipLaunchKernelGGL(trunk_fwd, dim3(grid), dim3(NWAVES * 64), LDS_BYTES, stream, a); }
#endif
}
```
